# Optimizing an MI355X kernel written in HIP

```python
import math
import jax, jax.numpy as jnp
from jax import lax
import numpy as np

D_MODEL = 1024
BATCH = 2
SEQ = 8192
DEPTH = 1

GRID_W = 64
PLE_DIM = 256
ATT_HEADS = 8
ATT_KV_HEADS = 2
HEAD_DIM = 128
Q_BLOCK = 128
ROPE_THETA = 10000.0
DN_HEADS = 8
DN_DK = 128
DN_DV = 128
CONV_K = 5
CHUNK = 64
EPS = 1e-6

ATT_W = ATT_HEADS * HEAD_DIM
KV_W = ATT_KV_HEADS * HEAD_DIM
DN_KW = DN_HEADS * DN_DK
DN_VW = DN_HEADS * DN_DV
IN_SIZES = (ATT_W, KV_W, KV_W, ATT_W,
            DN_KW, DN_KW, DN_VW, 2 * DN_HEADS, 2 * DN_HEADS, DN_VW,
            D_MODEL, D_MODEL)
IN_W = ATT_W + 2 * KV_W + ATT_W + 2 * DN_KW + DN_VW + 4 * DN_HEADS + DN_VW + 2 * D_MODEL

kernel_name = 'hybrid_gqa_axialrope_gated_deltanet_bidir_block'


def rms_norm(x, w):
    xf = x.astype(jnp.float32)
    y = xf * lax.rsqrt(jnp.mean(xf * xf, axis=-1, keepdims=True) + EPS)
    return (y * w.astype(jnp.float32)).astype(x.dtype)


def l2_norm(x):
    xf = x.astype(jnp.float32)
    return xf * lax.rsqrt(jnp.sum(xf * xf, axis=-1, keepdims=True) + EPS)


def split_cols(t):
    outs, start = [], 0
    for size in IN_SIZES:
        outs.append(t[..., start:start + size])
        start += size
    return outs


def axial_rope_angles(seq_len):
    rows = seq_len // GRID_W
    row = jnp.broadcast_to(jnp.arange(rows)[:, None], (rows, GRID_W)).reshape(seq_len)
    col = jnp.broadcast_to(jnp.arange(GRID_W)[None, :], (rows, GRID_W)).reshape(seq_len)
    n_freq = HEAD_DIM // 4
    inv_freq = ROPE_THETA ** (-jnp.arange(n_freq, dtype=jnp.float32) / n_freq)
    ang = jnp.concatenate([row.astype(jnp.float32)[:, None] * inv_freq,
                           col.astype(jnp.float32)[:, None] * inv_freq], axis=-1)
    return jnp.cos(ang), jnp.sin(ang)


def apply_rope(x, cos, sin):
    xf = x.astype(jnp.float32).reshape(*x.shape[:-1], HEAD_DIM // 2, 2)
    x0, x1 = xf[..., 0], xf[..., 1]
    out = jnp.stack([x0 * cos - x1 * sin, x0 * sin + x1 * cos], axis=-1)
    return out.reshape(x.shape).astype(x.dtype)


def gqa_attention(q, k, v):
    B, Hq, S, D = q.shape
    G = Hq // ATT_KV_HEADS
    nb = S // Q_BLOCK
    qb = q.reshape(B, ATT_KV_HEADS, G, nb, Q_BLOCK, D).transpose(3, 0, 1, 2, 4, 5)
    scale = D ** -0.5

    def block(qi):
        s = jnp.einsum('bkgqd,bksd->bkgqs', qi, k).astype(jnp.float32) * scale
        pr = jax.nn.softmax(s, axis=-1).astype(v.dtype)
        return jnp.einsum('bkgqs,bksd->bkgqd', pr, v)

    o = lax.map(block, qb)
    return o.transpose(1, 2, 3, 0, 4, 5).reshape(B, Hq, S, D)


def short_conv(x, w):
    C = x.shape[-1]
    return lax.conv_general_dilated(
        x, w[:, None, :].astype(x.dtype), window_strides=(1,),
        padding=((CONV_K // 2, CONV_K // 2),),
        dimension_numbers=('NWC', 'WIO', 'NWC'), feature_group_count=C)


def chunk_gated_delta_rule(q, k, v, g, beta):
    B, H, S, DK = q.shape
    DV = v.shape[-1]
    n = S // CHUNK
    q = q.reshape(B, H, n, CHUNK, DK)
    k = k.reshape(B, H, n, CHUNK, DK)
    v = v.reshape(B, H, n, CHUNK, DV)
    beta = beta.reshape(B, H, n, CHUNK)
    g = jnp.cumsum(g.reshape(B, H, n, CHUNK), axis=-1)
    tril = jnp.tril(jnp.ones((CHUNK, CHUNK), dtype=bool))
    eye = jnp.eye(CHUNK, dtype=jnp.float32)
    decay = jnp.exp(jnp.where(tril, g[..., :, None] - g[..., None, :], -jnp.inf))
    k_beta = k * beta[..., None]
    v_beta = v * beta[..., None]
    L = jnp.tril(jnp.einsum('bhncd,bhnjd->bhncj', k_beta, k) * decay, -1)
    T = lax.linalg.triangular_solve(eye + L, jnp.broadcast_to(eye, L.shape),
                                    left_side=True, lower=True, unit_diagonal=True)
    u = jnp.einsum('bhncj,bhnjv->bhncv', T, v_beta)
    w = jnp.einsum('bhncj,bhnjd->bhncd', T, k_beta * jnp.exp(g)[..., None])
    a_intra = jnp.einsum('bhncd,bhnjd->bhncj', q, k) * decay

    def step(state, xs):
        q_c, k_c, u_c, w_c, g_c, a_c = xs
        g_last = g_c[..., -1]
        v_new = u_c - jnp.einsum('bhcd,bhdv->bhcv', w_c, state)
        o = (jnp.einsum('bhcd,bhdv->bhcv', q_c * jnp.exp(g_c)[..., None], state)
             + jnp.einsum('bhcj,bhjv->bhcv', a_c, v_new))
        k_dec = k_c * jnp.exp(g_last[..., None] - g_c)[..., None]
        state = state * jnp.exp(g_last)[..., None, None] + jnp.einsum('bhcd,bhcv->bhdv', k_dec, v_new)
        return state, o

    front = lambda t: jnp.moveaxis(t, 2, 0)
    xs = (front(q), front(k), front(u), front(w), front(g), front(a_intra))
    state0 = jnp.zeros((B, H, DK, DV), jnp.float32)
    _, o = lax.scan(step, state0, xs)
    return jnp.moveaxis(o, 0, 2).reshape(B, H, S, DV)


def bidir_gated_deltanet(q, k, v, g, beta):
    flip = lambda t: jnp.flip(t, axis=2)
    o_f = chunk_gated_delta_rule(q, k, v, g[0], beta[0])
    o_b = flip(chunk_gated_delta_rule(flip(q), flip(k), flip(v), flip(g[1]), flip(beta[1])))
    return o_f + o_b


def setup_inputs(seed: int = 0) -> dict:
    key = jax.random.key(seed)
    ks = jax.random.split(key, 20)
    nrm = lambda k, shape, scale: jax.random.normal(k, shape, jnp.float32) * scale
    gain = lambda k, shape: 1.0 + 0.02 * jax.random.normal(k, shape, jnp.float32)
    dt = jnp.exp(jax.random.uniform(ks[8], (DEPTH, 2, DN_HEADS), jnp.float32,
                                    math.log(1e-3), math.log(1e-1)))
    return {
        'x': nrm(ks[0], (BATCH, SEQ, D_MODEL), 1.0),
        'p': nrm(ks[1], (DEPTH, BATCH, SEQ, PLE_DIM), 1.0),
        'norm_pre': gain(ks[2], (DEPTH, D_MODEL)),
        'w_in': nrm(ks[3], (DEPTH, D_MODEL, IN_W), D_MODEL ** -0.5),
        'q_norm': gain(ks[4], (DEPTH, HEAD_DIM)),
        'k_norm': gain(ks[5], (DEPTH, HEAD_DIM)),
        'conv_w': nrm(ks[6], (DEPTH, CONV_K, 2 * DN_KW + DN_VW), CONV_K ** -0.5),
        'a_log': jnp.log(jax.random.uniform(ks[7], (DEPTH, 2, DN_HEADS), jnp.float32, 1.0, 16.0)),
        'dt_bias': dt + jnp.log(-jnp.expm1(-dt)),
        'dn_norm': gain(ks[9], (DEPTH, DN_DV)),
        'w_br_att': nrm(ks[10], (DEPTH, ATT_W, D_MODEL), ATT_W ** -0.5),
        'w_br_dn': nrm(ks[11], (DEPTH, DN_VW, D_MODEL), DN_VW ** -0.5),
        'w_out': nrm(ks[12], (DEPTH, D_MODEL, D_MODEL), D_MODEL ** -0.5),
        'norm_post': gain(ks[13], (DEPTH, D_MODEL)),
        'w_ple_proj': nrm(ks[14], (DEPTH, PLE_DIM, D_MODEL), PLE_DIM ** -0.5),
        'w_ple_gate': nrm(ks[15], (DEPTH, D_MODEL, D_MODEL), D_MODEL ** -0.5),
        'ple_norm': gain(ks[16], (DEPTH, D_MODEL)),
    }


def reference(x, p, norm_pre, w_in, q_norm, k_norm, conv_w, a_log, dt_bias, dn_norm,
              w_br_att, w_br_dn, w_out, norm_post, w_ple_proj, w_ple_gate, ple_norm):
    B, S, _ = x.shape
    cos, sin = axial_rope_angles(S)
    heads = lambda t, nh, hd: t.reshape(B, S, nh, hd).transpose(0, 2, 1, 3)
    for i in range(DEPTH):
        h = rms_norm(x, norm_pre[i])
        (aq, ak, av, az, dq, dk, dv, db, da, dz, gate_att, gate_dn) = split_cols(h @ w_in[i])

        q = apply_rope(rms_norm(heads(aq, ATT_HEADS, HEAD_DIM), q_norm[i]), cos, sin)
        k = apply_rope(rms_norm(heads(ak, ATT_KV_HEADS, HEAD_DIM), k_norm[i]), cos, sin)
        v = heads(av, ATT_KV_HEADS, HEAD_DIM)
        o_att = gqa_attention(q, k, v).transpose(0, 2, 1, 3).reshape(B, S, ATT_W)
        y_att = (o_att * jax.nn.silu(az)) @ w_br_att[i]

        qkv = jax.nn.silu(short_conv(jnp.concatenate([dq, dk, dv], axis=-1), conv_w[i]))
        cq, ck, cv = qkv[..., :DN_KW], qkv[..., DN_KW:2 * DN_KW], qkv[..., 2 * DN_KW:]
        qd = l2_norm(heads(cq, DN_HEADS, DN_DK)) * (DN_DK ** -0.5)
        kd = l2_norm(heads(ck, DN_HEADS, DN_DK))
        vd = heads(cv, DN_HEADS, DN_DV).astype(jnp.float32)
        da4 = da.astype(jnp.float32).reshape(B, S, 2, DN_HEADS)
        db4 = db.astype(jnp.float32).reshape(B, S, 2, DN_HEADS)
        g = -jnp.exp(a_log[i].astype(jnp.float32)) * jax.nn.softplus(da4 + dt_bias[i].astype(jnp.float32))
        beta = jax.nn.sigmoid(db4)
        g = g.transpose(2, 0, 3, 1)
        beta = beta.transpose(2, 0, 3, 1)
        o_dn = bidir_gated_deltanet(qd, kd, vd, g, beta).astype(x.dtype)
        o_dn = rms_norm(o_dn.transpose(0, 2, 1, 3), dn_norm[i]).reshape(B, S, DN_VW)
        y_dn = (o_dn * jax.nn.silu(dz)) @ w_br_dn[i]

        mix = (jax.nn.sigmoid(gate_att) * y_att + jax.nn.sigmoid(gate_dn) * y_dn) @ w_out[i]
        x = x + rms_norm(mix, norm_post[i])

        e = p[i] @ w_ple_proj[i]
        x = x + rms_norm(jax.nn.sigmoid(x @ w_ple_gate[i]) * e, ple_norm[i])
    return x
```

```cpp
#include <hip/hip_runtime.h>
#include <hip/hip_cooperative_groups.h>
#include <cstdio>
#include <cstdint>
namespace cg = cooperative_groups;

using bf16 = unsigned short;
using bf16x8 = __attribute__((ext_vector_type(8))) short;
using s16x4  = __attribute__((ext_vector_type(4))) short;
using f32x16 = __attribute__((ext_vector_type(16))) float;
using f32x4  = __attribute__((ext_vector_type(4))) float;
using u32x4  = __attribute__((ext_vector_type(4))) unsigned;
using u32x2  = __attribute__((ext_vector_type(2))) unsigned;
typedef __bf16 bf16x2_t __attribute__((ext_vector_type(2)));
typedef float f32x2_t __attribute__((ext_vector_type(2)));
#define DI __device__ __forceinline__
#define MFMA(a, b, c) __builtin_amdgcn_mfma_f32_32x32x16_bf16((a), (b), (c), 0, 0, 0)

constexpr int M = 16384, SEQ = 8192, DM = 1024, INW = 8736, PLE = 256;
constexpr int C_AQ = 0, C_AK = 1024, C_AV = 1280, C_AZ = 1536, C_DQ = 2560, C_DB = 5632, C_DZ = 5664, C_GA = 6688, C_GD = 7712;
constexpr float EPS = 1e-6f;
constexpr size_t MiB = 1u << 20;
constexpr size_t WS_WT_IN = 0, WS_WT_BRA = 18 * MiB, WS_WT_BRD = 20 * MiB, WS_WT_OUT = 22 * MiB, WS_WT_PG = 24 * MiB, WS_WT_PP = 26 * MiB;
constexpr size_t WS_BAR = 29 * MiB + 131072;
constexpr size_t WS_ML = 31 * MiB;
constexpr size_t WS_HALO = 248 * MiB;
constexpr size_t WS_GB = 27 * MiB, WS_MISC = 29 * MiB, WS_GC = 30 * MiB;
constexpr size_t WS_H = 32 * MiB, WS_QA = 64 * MiB, WS_KA = 96 * MiB, WS_VA = 104 * MiB, WS_RAW = 112 * MiB, WS_TM = 208 * MiB, WS_PB = 240 * MiB;
constexpr size_t WS_MIXIN = 112 * MiB, WS_MIXO = 144 * MiB, WS_X1B = 208 * MiB, WS_END = 256 * MiB;
constexpr int LDS_BYTES = 141312 + 64;

struct Params {
  const float *x, *p, *norm_pre, *w_in, *q_norm, *k_norm, *conv_w, *a_log, *dt_bias, *dn_norm, *w_br_att, *w_br_dn, *w_out, *norm_post, *w_ple_proj, *w_ple_gate, *ple_norm;
  float* out; char* ws; int ph_lo, ph_hi;
};

DI float bf2f(unsigned short v) { return __uint_as_float(((unsigned)v) << 16); }
DI unsigned short f2bf(float f) { unsigned u = __float_as_uint(f); u += 0x7fffu + ((u >> 16) & 1u); return (unsigned short)(u >> 16); }
DI unsigned pk2(float lo, float hi) { f32x2_t v = {lo, hi}; bf16x2_t b = __builtin_convertvector(v, bf16x2_t); return __builtin_bit_cast(unsigned, b); }
DI int crow(int r, int hi) { return (r & 3) + 8 * (r >> 2) + 4 * hi; }
#define CRC(r) (((r) & 3) + 8 * ((r) >> 2))
DI float wave_sum(float v) { for (int o = 32; o > 0; o >>= 1) v += __shfl_xor(v, o); return v; }
DI float half_sum(float v) { for (int o = 16; o > 0; o >>= 1) v += __shfl_xor(v, o); return v; }
DI float sigmoidf_(float x) { return __builtin_amdgcn_rcpf(1.f + __expf(-x)); }
DI float siluf_(float x) { return x * __builtin_amdgcn_rcpf(1.f + __expf(-x)); }

DI int remap_in(int n) {
  if (n < 1536) return n; if (n < 2560) return n - 1536 + 4864; if (n < 5664) return n - 2560 + 1536; if (n < 6688) return n - 5664 + 5888; return n - 6688 + 6912;
}
template <bool REMAP> DI void transpose_w(const float* __restrict__ W, int K, int N, bf16* __restrict__ WT, float* sl) {
  const int tid = threadIdx.x;
  const int ktiles = K / 64, ntiles = (N + 63) / 64;
  for (int tile = blockIdx.x; tile < ktiles * ntiles; tile += gridDim.x) {
    const int kt = tile % ktiles, nt = tile / ktiles;
#pragma unroll
    for (int i = 0; i < 8; ++i) {
      const int kl = (tid >> 6) + i * 8, nl = tid & 63, n = nt * 64 + nl;
      sl[kl * 65 + nl] = (n < N) ? W[(size_t)(kt * 64 + kl) * N + n] : 0.f;
    }
    __syncthreads();
    const int nl = tid >> 3, kc = (tid & 7) * 8, n = nt * 64 + nl;
    if (n < N) {
      u32x4 w;
      w[0] = pk2(sl[(kc + 0) * 65 + nl], sl[(kc + 1) * 65 + nl]); w[1] = pk2(sl[(kc + 2) * 65 + nl], sl[(kc + 3) * 65 + nl]);
      w[2] = pk2(sl[(kc + 4) * 65 + nl], sl[(kc + 5) * 65 + nl]); w[3] = pk2(sl[(kc + 6) * 65 + nl], sl[(kc + 7) * 65 + nl]);
      *(u32x4*)(WT + (size_t)(REMAP ? remap_in(n) : n) * K + kt * 64 + kc) = w;
    }
    __syncthreads();
  }
}

DI void phase0(const Params& P, char* lds) {
  const int tid = threadIdx.x, wave = tid >> 6, lane = tid & 63;
  char* ws = P.ws;
  { float2* cs = (float2*)(ws + WS_MISC);
    for (int idx = blockIdx.x * 512 + tid; idx < 4096; idx += gridDim.x * 512) {
      const int pos = idx >> 5, fi = idx & 31;
      const float inv = exp2f(-(float)fi * (13.287712379549449f / 32.f));
      const float ang = (float)pos * inv;
      cs[idx] = make_float2(cosf(ang), sinf(ang));
    } }
  transpose_w<true>(P.w_in, 1024, INW, (bf16*)(ws + WS_WT_IN), (float*)lds);
  transpose_w<false>(P.w_br_att, 1024, 1024, (bf16*)(ws + WS_WT_BRA), (float*)lds);
  transpose_w<false>(P.w_br_dn, 1024, 1024, (bf16*)(ws + WS_WT_BRD), (float*)lds);
  transpose_w<false>(P.w_out, 1024, 1024, (bf16*)(ws + WS_WT_OUT), (float*)lds);
  transpose_w<false>(P.w_ple_gate, 1024, 1024, (bf16*)(ws + WS_WT_PG), (float*)lds);
  transpose_w<false>(P.w_ple_proj, 256, 1024, (bf16*)(ws + WS_WT_PP), (float*)lds);
  bf16* H = (bf16*)(ws + WS_H);
  for (int row = blockIdx.x * 8 + wave; row < M; row += gridDim.x * 8) {
    const float* xr = P.x + (size_t)row * DM;
    f32x4 v[4]; float ss = 0.f;
#pragma unroll
    for (int i = 0; i < 4; ++i) { v[i] = *(const f32x4*)(xr + i * 256 + lane * 4); ss += v[i][0] * v[i][0] + v[i][1] * v[i][1] + v[i][2] * v[i][2] + v[i][3] * v[i][3]; }
    ss = wave_sum(ss);
    const float rstd = rsqrtf(ss * (1.f / DM) + EPS);
#pragma unroll
    for (int i = 0; i < 4; ++i) {
      const f32x4 w = *(const f32x4*)(P.norm_pre + i * 256 + lane * 4);
      u32x2 o = {pk2(v[i][0] * rstd * w[0], v[i][1] * rstd * w[1]), pk2(v[i][2] * rstd * w[2], v[i][3] * rstd * w[3])};
      *(u32x2*)(H + (size_t)row * DM + i * 256 + lane * 4) = o;
    }
  }
}

DI void phase_pconv(const Params& P) {
  const int tid = threadIdx.x; char* ws = P.ws;
  bf16* PB = (bf16*)(ws + WS_PB);
  for (size_t i = (size_t)blockIdx.x * 512 + tid; i < (size_t)M * PLE / 8; i += (size_t)gridDim.x * 512) {
    const f32x4 a = *(const f32x4*)(P.p + i * 8), b = *(const f32x4*)(P.p + i * 8 + 4);
    u32x4 o = {pk2(a[0], a[1]), pk2(a[2], a[3]), pk2(b[0], b[1]), pk2(b[2], b[3])};
    *(u32x4*)(PB + i * 8) = o;
  }
}

namespace pg8 {
#define PG8_LAS __attribute__((address_space(3)))
typedef unsigned short bf16_t;
typedef short bf16x8 __attribute__((ext_vector_type(8)));
typedef float f32x4 __attribute__((ext_vector_type(4)));
typedef unsigned u32x4 __attribute__((ext_vector_type(4)));
constexpr int BM = 256, BK = 64, HALF = 128, HTB = HALF * BK * 2  , STAGE_BYTES = 8 * HTB, NXCD = 8, WGM = 8;

__host__ __device__ __forceinline__ int lds_byte(int r, int c) { const int st = (r >> 4) * 2 + (c >> 5), rr = r & 15, cc = c & 31, ob = rr * 64 + cc * 2; return st * 1024 + (ob ^ (((ob >> 9) & 1) << 5)); }
__host__ __device__ __forceinline__ void stage_rc(int b, int& R, int& C) { const int st = b / 1024, sb = b % 1024, swz = sb ^ (((sb >> 9) & 1) << 5); R = (st >> 1) * 16 + swz / 64; C = (st & 1) * 32 + (swz % 64) / 2; }
__host__ __device__ __forceinline__ int perm32(int rho) { const int n = rho >> 4, i = rho & 15; return 8 * (i >> 2) + 4 * n + (i & 3); }

struct Unit { int pm, pn, kind; };
struct Gemm { const bf16_t* A; const bf16_t* Bt; int M, N, K; };

struct StaticOrder {
    int nM, nN, nwg, G, c;
    __host__ __device__ void init(int M, int N, int G_, int c_) { nM = M / BM; nN = N / BM; nwg = nM * nN; G = G_; c = c_; }
    __host__ __device__ bool next(int i, Unit& u) const {
        const long L = (long)i * G + c; if (L >= nwg) return false;
        int wgid = (int)L; { const int q = nwg / NXCD, r = nwg % NXCD, xcd = wgid % NXCD, off = wgid / NXCD; wgid = (xcd < r ? xcd * (q + 1) : r * (q + 1) + (xcd - r) * q) + off; }
        const int nig = WGM * nN, gid = wgid / nig, fm = gid * WGM, gsz = (nM - fm) < WGM ? (nM - fm) : WGM;
        u.pm = fm + ((wgid % nig) % gsz); u.pn = (wgid % nig) / gsz; u.kind = 0; return true;
    }
    __device__ __forceinline__ void ab(const Gemm& g, const Unit& u, size_t tstep, const char*& A, const char*& B) const { A = (const char*)g.A + (size_t)u.pm * tstep; B = (const char*)g.Bt + (size_t)u.pn * tstep; }
    __device__ __forceinline__ void a_ready(const Unit&) const {}
    __device__ __forceinline__ void done(const Unit&) const {}
};
template <class Epi, class Sched, bool ALIGN_EPI = false, bool SP2 = false>
__device__ __forceinline__ void gemm_phase(PG8_LAS unsigned char* lds, const Gemm g, const Sched& S, const Epi& E) {
    const int tid = threadIdx.x, wid = __builtin_amdgcn_readfirstlane(tid >> 6), lane = tid & 63, wr = wid >> 2, wc = wid & 3, fr = lane & 15, fq = lane >> 4;
    const int K = g.K, nt = K / BK;
    unsigned voffA[2], voffB[2];
#pragma unroll
    for (int i = 0; i < 2; ++i) { int R, C; stage_rc(tid * 16 + i * 8192, R, C); const int Rb = Epi::PERM ? ((R & ~31) + perm32(R & 31)) : R;
        voffA[i] = (unsigned)(R * K + C) * 2u; voffB[i] = (unsigned)(Rb * K + C) * 2u; }
    const size_t kstep = (size_t)(BK * 2);
    const size_t hstep = (size_t)HALF * K * 2;
    const size_t tstep = 2 * hstep;
    const unsigned ldsw = (unsigned)wid * 1024u;
    const int aoff = lds_byte(wr * 64 + fr, fq * 8), boff = lds_byte(wc * 32 + fr, fq * 8);
#define PG8_SA(b, h) (((b) * 2 + (h)) * HTB)
#define PG8_SB(b, h) ((4 + (b) * 2 + (h)) * HTB)
#define PG8_STAGE(bufoff, gbase, voff) do { _Pragma("unroll") for (int _i = 0; _i < 2; ++_i) \
        __builtin_amdgcn_global_load_lds((const unsigned*)((const char*)(gbase) + (voff)[_i]), (PG8_LAS unsigned*)(lds + (bufoff) + ldsw + _i * 8192), 16, 0, 0); } while (0)
#define PG8_LDA(dst, b, h) do { _Pragma("unroll") for (int m = 0; m < 4; ++m) _Pragma("unroll") for (int k = 0; k < 2; ++k) dst[m][k] = *(const PG8_LAS bf16x8*)(lds + PG8_SA(b, h) + aoff + m * 2048 + k * 1024); } while (0)
#define PG8_LDB(dst, b, h) do { _Pragma("unroll") for (int n = 0; n < 2; ++n) _Pragma("unroll") for (int k = 0; k < 2; ++k) dst[n][k] = *(const PG8_LAS bf16x8*)(lds + PG8_SB(b, h) + boff + n * 2048 + k * 1024); } while (0)
#define PG8_MMA(ai, bj, At, Bt) do { __builtin_amdgcn_s_setprio(1); _Pragma("unroll") for (int m = 0; m < 4; ++m) _Pragma("unroll") for (int n = 0; n < 2; ++n) _Pragma("unroll") for (int k = 0; k < 2; ++k) \
        acc[ai][bj][m][n] = __builtin_amdgcn_mfma_f32_16x16x32_bf16(Bt[n][k], At[m][k], acc[ai][bj][m][n], 0, 0, 0); __builtin_amdgcn_s_setprio(0); } while (0)
#define PG8_WAIT_V(n) asm volatile("s_waitcnt vmcnt(" #n ")" ::: "memory")
#define PG8_WAIT_L(n) asm volatile("s_waitcnt lgkmcnt(" #n ")" ::: "memory")
#define PG8_BAR __builtin_amdgcn_s_barrier()
#define PG8_SCHED __builtin_amdgcn_sched_barrier(0)
    Unit cur, nxt; int ui = 0;
    if (!S.next(0, cur)) return;
    f32x4 acc[2][2][4][2];
#pragma unroll
    for (int a = 0; a < 2; ++a)
#pragma unroll
        for (int b = 0; b < 2; ++b)
#pragma unroll
            for (int m = 0; m < 4; ++m)
#pragma unroll
                for (int n = 0; n < 2; ++n) acc[a][b][m][n] = (f32x4){0.f, 0.f, 0.f, 0.f};
    bf16x8 At[4][2], B0[2][2], B1[2][2];
    const char* cA; const char* cB; S.ab(g, cur, tstep, cA, cB);
    S.a_ready(cur);
    if constexpr (SP2) {
        PG8_STAGE(PG8_SB(0, 0), cB, voffB); PG8_STAGE(PG8_SB(0, 1), cB + hstep, voffB); PG8_STAGE(PG8_SA(0, 0), cA, voffA); PG8_STAGE(PG8_SA(0, 1), cA + hstep, voffA);
        if (wr == 1) PG8_BAR;
        PG8_WAIT_V(2); PG8_BAR;
        PG8_STAGE(PG8_SB(1, 0), cB + kstep, voffB); PG8_STAGE(PG8_SA(1, 0), cA + kstep, voffA); PG8_STAGE(PG8_SB(1, 1), cB + hstep + kstep, voffB);
        PG8_WAIT_V(6); PG8_BAR;
    } else {
        PG8_STAGE(PG8_SB(0, 0), cB, voffB); PG8_STAGE(PG8_SA(0, 0), cA, voffA); PG8_STAGE(PG8_SB(0, 1), cB + hstep, voffB); PG8_STAGE(PG8_SA(0, 1), cA + hstep, voffA);
        if (wr == 1) PG8_BAR;
        PG8_WAIT_V(4); PG8_BAR;
        PG8_STAGE(PG8_SB(1, 0), cB + kstep, voffB); PG8_STAGE(PG8_SA(1, 0), cA + kstep, voffA); PG8_STAGE(PG8_SB(1, 1), cB + hstep + kstep, voffB);
        PG8_WAIT_V(6); PG8_BAR;
    }
    for (;;) {
        const bool has_next = S.next(ui + 1, nxt);
        const char* nA = cA; const char* nB = cB; if (has_next) S.ab(g, nxt, tstep, nA, nB);
        for (int t = 0; t < nt; t += 2) {
            const bool last = (t == nt - 2);
            const char* a1 = cA + (size_t)(t + 1) * kstep;
            const char* a2 = last ? nA : cA + (size_t)(t + 2) * kstep; const char* b2 = last ? nB : cB + (size_t)(t + 2) * kstep;
            const char* a3 = a2 + kstep; const char* b3 = b2 + kstep;
            if (last && has_next) S.a_ready(nxt);
            if constexpr (SP2) {
            PG8_LDB(B0, 0, 0); PG8_LDB(B1, 0, 1); PG8_SCHED; PG8_LDA(At, 0, 0); PG8_STAGE(PG8_SA(1, 1), a1 + hstep, voffA);
            PG8_WAIT_V(8); PG8_WAIT_L(0); PG8_BAR; PG8_MMA(0, 0, At, B0); PG8_MMA(0, 1, At, B1); PG8_BAR; PG8_SCHED;
            PG8_LDA(At, 0, 1); PG8_STAGE(PG8_SB(0, 0), b2, voffB); PG8_STAGE(PG8_SB(0, 1), b2 + hstep, voffB); PG8_STAGE(PG8_SA(0, 0), a2, voffA);
            PG8_WAIT_V(8); PG8_WAIT_L(0); PG8_BAR; PG8_MMA(1, 0, At, B0); PG8_MMA(1, 1, At, B1); PG8_BAR; PG8_SCHED;
            PG8_LDB(B0, 1, 0); PG8_LDB(B1, 1, 1); PG8_SCHED; PG8_LDA(At, 1, 0); PG8_STAGE(PG8_SA(0, 1), a2 + hstep, voffA);
            PG8_WAIT_V(8); PG8_WAIT_L(0); PG8_BAR; PG8_MMA(0, 0, At, B0); PG8_MMA(0, 1, At, B1); PG8_BAR; PG8_SCHED;
            PG8_LDA(At, 1, 1); PG8_STAGE(PG8_SB(1, 0), b3, voffB); PG8_STAGE(PG8_SB(1, 1), b3 + hstep, voffB); PG8_STAGE(PG8_SA(1, 0), a3, voffA);
            PG8_WAIT_V(8); PG8_WAIT_L(0); PG8_BAR; PG8_MMA(1, 0, At, B0); PG8_MMA(1, 1, At, B1); PG8_BAR; PG8_SCHED;
            } else {
            PG8_LDB(B0, 0, 0); PG8_SCHED; PG8_LDA(At, 0, 0); PG8_STAGE(PG8_SA(1, 1), a1 + hstep, voffA);
            PG8_WAIT_L(8); PG8_BAR; PG8_WAIT_L(0); PG8_MMA(0, 0, At, B0); PG8_BAR; PG8_SCHED;
            PG8_LDB(B1, 0, 1); PG8_STAGE(PG8_SB(0, 0), b2, voffB);
            PG8_BAR; PG8_WAIT_L(0); PG8_MMA(0, 1, At, B1); PG8_BAR;
            PG8_LDA(At, 0, 1); PG8_STAGE(PG8_SA(0, 0), a2, voffA);
            PG8_BAR; PG8_WAIT_L(0); PG8_MMA(1, 0, At, B0); PG8_BAR; PG8_SCHED;
            PG8_STAGE(PG8_SB(0, 1), b2 + hstep, voffB);
            PG8_WAIT_V(6); PG8_BAR; PG8_MMA(1, 1, At, B1); PG8_BAR;
            PG8_LDB(B0, 1, 0); PG8_SCHED; PG8_LDA(At, 1, 0); PG8_STAGE(PG8_SA(0, 1), a2 + hstep, voffA);
            PG8_WAIT_L(8); PG8_BAR; PG8_WAIT_L(0); PG8_MMA(0, 0, At, B0); PG8_BAR; PG8_SCHED;
            PG8_LDB(B1, 1, 1); PG8_STAGE(PG8_SB(1, 0), b3, voffB);
            PG8_BAR; PG8_WAIT_L(0); PG8_MMA(0, 1, At, B1); PG8_BAR;
            PG8_LDA(At, 1, 1); PG8_STAGE(PG8_SA(1, 0), a3, voffA);
            PG8_BAR; PG8_WAIT_L(0); PG8_MMA(1, 0, At, B0); PG8_BAR; PG8_SCHED;
            PG8_STAGE(PG8_SB(1, 1), b3 + hstep, voffB);
            PG8_WAIT_V(6); PG8_BAR; PG8_MMA(1, 1, At, B1); PG8_BAR;
            }
        }
        if constexpr (ALIGN_EPI) { if (wr == 0) PG8_BAR; }
        if constexpr (!Epi::AFTER_DRAIN) { E(acc, cur, wr, wc, fr, fq); S.done(cur); }
        if (!has_next) break;
#pragma unroll
        for (int a = 0; a < 2; ++a)
#pragma unroll
            for (int b = 0; b < 2; ++b)
#pragma unroll
                for (int m = 0; m < 4; ++m)
#pragma unroll
                    for (int n = 0; n < 2; ++n) acc[a][b][m][n] = (f32x4){0.f, 0.f, 0.f, 0.f};
        cur = nxt; cA = nA; cB = nB; ++ui;
        if constexpr (ALIGN_EPI) { if (wr == 1) PG8_BAR; }
    }
    PG8_WAIT_V(0);
    if constexpr (!ALIGN_EPI) { if (wr == 0) PG8_BAR; }
    PG8_BAR;
    if constexpr (Epi::AFTER_DRAIN) { E.fused(acc, cur, wr, wc, fr, fq, lds, wid, lane); S.done(cur); }
#undef PG8_SA
#undef PG8_SB
#undef PG8_STAGE
#undef PG8_LDA
#undef PG8_LDB
#undef PG8_MMA
#undef PG8_WAIT_V
#undef PG8_WAIT_L
#undef PG8_BAR
#undef PG8_SCHED
}


}

constexpr int XCH_OFF = 131072;
DI unsigned lo16f(unsigned w) { return w << 16; }
DI void unpack8(const u32x4 w, float* o) {
#pragma unroll
  for (int e = 0; e < 4; ++e) { o[2 * e] = __uint_as_float(w[e] << 16); o[2 * e + 1] = __uint_as_float(w[e] & 0xffff0000u); }
}
DI u32x4 pack8(const float* v) { return u32x4{pk2(v[0], v[1]), pk2(v[2], v[3]), pk2(v[4], v[5]), pk2(v[6], v[7])}; }
#define XCH_IDX(wr, ai, m, bj, fr) ((((((wr) * 2 + (ai)) * 4 + (m)) * 2 + (bj)) * 16 + (fr)) * 4)

struct EpiG1 {
  static constexpr bool PERM = true, AFTER_DRAIN = false;
  char* ws; const float* q_norm; const float* k_norm; const float* a_log; const float* dt_bias; float* xch;
  DI void operator()(const pg8::f32x4 (&acc)[2][2][4][2], const pg8::Unit& u, int wr, int wc, int fr, int fq) const {
    const int pn = u.pn, row0 = u.pm * 256 + wr * 64 + fr, c0 = wc * 32 + fq * 8;
    if (pn < 5) {
#pragma unroll
      for (int ai = 0; ai < 2; ++ai)
#pragma unroll
        for (int m = 0; m < 4; ++m)
#pragma unroll
          for (int bj = 0; bj < 2; ++bj) {
            const pg8::f32x4 a = acc[ai][bj][m][0], b = acc[ai][bj][m][1];
            float s = a[0] * a[0] + a[1] * a[1] + a[2] * a[2] + a[3] * a[3] + b[0] * b[0] + b[1] * b[1] + b[2] * b[2] + b[3] * b[3];
            s += __shfl_xor(s, 16); s += __shfl_xor(s, 32);
            if (fq == 0) xch[XCH_IDX(wr, ai, m, bj, fr) + wc] = s;
          }
      asm volatile("s_waitcnt lgkmcnt(0)" ::: "memory");
      __builtin_amdgcn_s_barrier();
      const float* nw = pn < 4 ? q_norm : k_norm;
      const f32x4 w0 = *(const f32x4*)(nw + c0), w1 = *(const f32x4*)(nw + c0 + 4);
      const float2* cs = (const float2*)(ws + WS_MISC);
#pragma unroll
      for (int ai = 0; ai < 2; ++ai)
#pragma unroll
        for (int m = 0; m < 4; ++m) {
          const int row = row0 + ai * 128 + m * 16, t = row & (SEQ - 1);
          const int pos = (wc < 2) ? (t >> 6) : (t & 63);
          const float2* cp = cs + pos * 32 + ((c0 >> 1) & 31);
          const f32x4 cs0 = *(const f32x4*)cp, cs1 = *(const f32x4*)(cp + 2);
#pragma unroll
          for (int bj = 0; bj < 2; ++bj) {
            const f32x4 ps = *(const f32x4*)(xch + XCH_IDX(wr, ai, m, bj, fr));
            const float rstd = rsqrtf((ps[0] + ps[1] + ps[2] + ps[3]) * (1.f / 128.f) + EPS);
            const pg8::f32x4 a = acc[ai][bj][m][0], b = acc[ai][bj][m][1];
            float v[8] = {a[0] * rstd * w0[0], a[1] * rstd * w0[1], a[2] * rstd * w0[2], a[3] * rstd * w0[3],
                          b[0] * rstd * w1[0], b[1] * rstd * w1[1], b[2] * rstd * w1[2], b[3] * rstd * w1[3]};
            float o[8];
            o[0] = v[0] * cs0[0] - v[1] * cs0[1]; o[1] = v[0] * cs0[1] + v[1] * cs0[0];
            o[2] = v[2] * cs0[2] - v[3] * cs0[3]; o[3] = v[2] * cs0[3] + v[3] * cs0[2];
            o[4] = v[4] * cs1[0] - v[5] * cs1[1]; o[5] = v[4] * cs1[1] + v[5] * cs1[0];
            o[6] = v[6] * cs1[2] - v[7] * cs1[3]; o[7] = v[6] * cs1[3] + v[7] * cs1[2];
            bf16* dst = pn < 4 ? (bf16*)(ws + WS_QA) + (size_t)row * 1024 + (2 * pn + bj) * 128 + c0 : (bf16*)(ws + WS_KA) + (size_t)row * 256 + bj * 128 + c0;
            *(u32x4*)dst = pack8(o);
          }
          asm volatile("" ::: "memory");
        }
    } else if (pn < 18) {
#pragma unroll
      for (int ai = 0; ai < 2; ++ai)
#pragma unroll
        for (int m = 0; m < 4; ++m) {
          const int row = row0 + ai * 128 + m * 16, c64 = row & 63;
#pragma unroll
          for (int bj = 0; bj < 2; ++bj) {
            const pg8::f32x4 a = acc[ai][bj][m][0], b = acc[ai][bj][m][1];
            const u32x4 w = {pk2(a[0], a[1]), pk2(a[2], a[3]), pk2(b[0], b[1]), pk2(b[2], b[3])};
            if (pn == 5) *(u32x4*)((bf16*)(ws + WS_VA) + (size_t)row * 256 + bj * 128 + c0) = w;
            else {
              const int col = (pn - 6) * 256 + bj * 128 + c0;
              *(u32x4*)((bf16*)(ws + WS_RAW) + (size_t)row * 3072 + col) = w;
              if (c64 < 2 || c64 >= 62) *(u32x4*)((bf16*)(ws + WS_HALO) + ((size_t)(row >> 6) * 4 + (c64 < 2 ? c64 : c64 - 60)) * 3072 + col) = w;
            }
          }
          asm volatile("" ::: "memory");
        }
    } else if (wc == 0) {
      float* GB = (float*)(ws + WS_GB);
      int fqq = fq; asm volatile("" : "+v"(fqq));
#pragma unroll
      for (int n = 0; n < 2; ++n) {
        const int col = fqq * 8 + n * 4;
        f32x4 al = {0.f, 0.f, 0.f, 0.f}, dtb = {0.f, 0.f, 0.f, 0.f};
        if (col >= 16) { const f32x4 t = *(const f32x4*)(a_log + col - 16); al = f32x4{__expf(t[0]), __expf(t[1]), __expf(t[2]), __expf(t[3])}; dtb = *(const f32x4*)(dt_bias + col - 16); }
#pragma unroll
        for (int ai = 0; ai < 2; ++ai)
#pragma unroll
          for (int m = 0; m < 4; ++m) {
            const int row = row0 + ai * 128 + m * 16;
            const pg8::f32x4 a = acc[ai][0][m][n];
            f32x4 o;
#pragma unroll
            for (int e = 0; e < 4; ++e) {
              if (col < 16) o[e] = sigmoidf_(a[e]);
              else { const float z = a[e] + dtb[e]; const float sp = z > 20.f ? z : log1pf(__expf(z)); o[e] = -al[e] * sp; }
            }
            *(f32x4*)(GB + (size_t)row * 32 + col) = o;
          }
      }
    }
  }
};

struct EpiG3 {
  static constexpr bool PERM = true, AFTER_DRAIN = false;
  bf16* QA; bf16* OF; const bf16* OB; const float* dn_norm; float* xch; const bf16* PO; const float* ML;
  DI void operator()(const pg8::f32x4 (&acc)[2][2][4][2], const pg8::Unit& u, int wr, int wc, int fr, int fq) const {
    const int pn = u.pn, row0 = u.pm * 256 + wr * 64 + fr, c0 = wc * 32 + fq * 8;
    if (pn < 4) {
#pragma unroll
      for (int ai = 0; ai < 2; ++ai)
#pragma unroll
        for (int m = 0; m < 4; ++m)
#pragma unroll
          for (int bj = 0; bj < 2; ++bj) {
            const int row = row0 + ai * 128 + m * 16;
            bf16* p = QA + (size_t)row * 1024 + pn * 256 + bj * 128 + c0;
            float o[8];
            if (pn == 3 && u.pm >= 32) {
              const int pc0 = (bj * 32 + ((row - SEQ) >> 8)) * 4, rr = row & 255;
              float mq[4], lq[4], mmax = -3.0e38f;
#pragma unroll
              for (int q = 0; q < 4; ++q) { const float2 t = *(const float2*)(ML + ((size_t)(pc0 + q) * 256 + rr) * 2); mq[q] = t.x; lq[q] = t.y; mmax = fmaxf(mmax, t.x); }
              float wsum = 0.f;
#pragma unroll
              for (int e = 0; e < 8; ++e) o[e] = 0.f;
#pragma unroll
              for (int q = 0; q < 4; ++q) {
                const float wq = __builtin_amdgcn_exp2f((mq[q] - mmax) * (0.088388347648318440f * 1.4426950408889634f)) * lq[q];
                float x[8]; unpack8(*(const u32x4*)(PO + ((size_t)(pc0 + q) * 256 + rr) * 128 + c0), x);
#pragma unroll
                for (int e = 0; e < 8; ++e) o[e] += wq * x[e];
                wsum += wq;
              }
              const float inv = 1.f / wsum;
#pragma unroll
              for (int e = 0; e < 8; ++e) o[e] *= inv;
            } else unpack8(*(const u32x4*)p, o);
            const pg8::f32x4 a = acc[ai][bj][m][0], b = acc[ai][bj][m][1];
            o[0] *= siluf_(a[0]); o[1] *= siluf_(a[1]); o[2] *= siluf_(a[2]); o[3] *= siluf_(a[3]);
            o[4] *= siluf_(b[0]); o[5] *= siluf_(b[1]); o[6] *= siluf_(b[2]); o[7] *= siluf_(b[3]);
            *(u32x4*)p = pack8(o);
          }
    } else {
      const f32x4 w0 = *(const f32x4*)(dn_norm + c0), w1 = *(const f32x4*)(dn_norm + c0 + 4);
#pragma unroll
      for (int ai = 0; ai < 2; ++ai)
#pragma unroll
        for (int m = 0; m < 4; ++m)
#pragma unroll
          for (int bj = 0; bj < 2; ++bj) {
            const size_t idx = (size_t)(row0 + ai * 128 + m * 16) * 1024 + (pn - 4) * 256 + bj * 128 + c0;
            float x[8], y[8]; unpack8(*(const u32x4*)(OF + idx), x); unpack8(*(const u32x4*)(OB + idx), y);
            float s = 0.f;
#pragma unroll
            for (int e = 0; e < 8; ++e) { x[e] += y[e]; s += x[e] * x[e]; }
            s += __shfl_xor(s, 16); s += __shfl_xor(s, 32);
            if (fq == 0) xch[XCH_IDX(wr, ai, m, bj, fr) + wc] = s;
          }
      asm volatile("s_waitcnt lgkmcnt(0)" ::: "memory");
      __builtin_amdgcn_s_barrier();
#pragma unroll
      for (int ai = 0; ai < 2; ++ai)
#pragma unroll
        for (int m = 0; m < 4; ++m)
#pragma unroll
          for (int bj = 0; bj < 2; ++bj) {
            const size_t idx = (size_t)(row0 + ai * 128 + m * 16) * 1024 + (pn - 4) * 256 + bj * 128 + c0;
            float x[8], y[8]; unpack8(*(const u32x4*)(OF + idx), x); unpack8(*(const u32x4*)(OB + idx), y);
            const f32x4 ps = *(const f32x4*)(xch + XCH_IDX(wr, ai, m, bj, fr));
            const float rstd = rsqrtf((ps[0] + ps[1] + ps[2] + ps[3]) * (1.f / 128.f) + EPS);
            const pg8::f32x4 a = acc[ai][bj][m][0], b = acc[ai][bj][m][1];
            float o[8];
            o[0] = (x[0] + y[0]) * rstd * w0[0] * siluf_(a[0]); o[1] = (x[1] + y[1]) * rstd * w0[1] * siluf_(a[1]);
            o[2] = (x[2] + y[2]) * rstd * w0[2] * siluf_(a[2]); o[3] = (x[3] + y[3]) * rstd * w0[3] * siluf_(a[3]);
            o[4] = (x[4] + y[4]) * rstd * w1[0] * siluf_(b[0]); o[5] = (x[5] + y[5]) * rstd * w1[1] * siluf_(b[1]);
            o[6] = (x[6] + y[6]) * rstd * w1[2] * siluf_(b[2]); o[7] = (x[7] + y[7]) * rstd * w1[3] * siluf_(b[3]);
            *(u32x4*)(OF + idx) = pack8(o);
          }
    }
  }
};

template <int MODE> struct EpiEW {
  static constexpr bool PERM = true, AFTER_DRAIN = false;
  bf16* ob; float* of; const bf16* in1;
  DI void operator()(const pg8::f32x4 (&acc)[2][2][4][2], const pg8::Unit& u, int wr, int wc, int fr, int fq) const {
    const int row0 = u.pm * 256 + wr * 64 + fr, c0 = u.pn * 256 + wc * 32 + fq * 8;
#pragma unroll
    for (int ai = 0; ai < 2; ++ai)
#pragma unroll
      for (int m = 0; m < 4; ++m)
#pragma unroll
        for (int bj = 0; bj < 2; ++bj) {
          const size_t idx = (size_t)(row0 + ai * 128 + m * 16) * 1024 + bj * 128 + c0;
          const pg8::f32x4 a = acc[ai][bj][m][0], b = acc[ai][bj][m][1];
          float v[8] = {a[0], a[1], a[2], a[3], b[0], b[1], b[2], b[3]};
          float g[8];
          if (MODE == 1 || MODE == 2 || MODE == 5 || MODE == 6) unpack8(*(const u32x4*)(in1 + idx), g);
          if (MODE == 0) {
#pragma unroll
            for (int e = 0; e < 8; ++e) v[e] = sigmoidf_(v[e]);
          } else if (MODE == 1) {
#pragma unroll
            for (int e = 0; e < 8; ++e) v[e] *= g[e];
          } else if (MODE == 2) {
            float p[8]; unpack8(*(const u32x4*)(ob + idx), p);
#pragma unroll
            for (int e = 0; e < 8; ++e) v[e] = p[e] + g[e] * v[e];
          } else if (MODE == 5 || MODE == 6) {
#pragma unroll
            for (int e = 0; e < 8; ++e) v[e] = sigmoidf_(v[e]) * g[e];
          }
          if (MODE == 3 || MODE == 5) { *(f32x4*)(of + idx) = f32x4{v[0], v[1], v[2], v[3]}; *(f32x4*)(of + idx + 4) = f32x4{v[4], v[5], v[6], v[7]}; }
          else *(u32x4*)(ob + idx) = pack8(v);
        }
  }
};

template <class Epi, bool ALIGN> DI void run_gemm(char* lds, const bf16* A, const bf16* Bt, int N, int K, const Epi& E) {
  pg8::Gemm g{A, Bt, M, N, K};
  pg8::StaticOrder S; S.init(M, N, (int)gridDim.x, (int)blockIdx.x);
  pg8::gemm_phase<Epi, pg8::StaticOrder, ALIGN, true>((PG8_LAS unsigned char*)lds, g, S, E);
}

constexpr int R_G3 = 4864, R_GA = 6912, R_GD = 7936;
DI void phase_g1(const Params& P, char* lds) {
  char* ws = P.ws;
  EpiG1 E{ws, P.q_norm, P.k_norm, P.a_log, P.dt_bias, (float*)(lds + XCH_OFF)};
  run_gemm<EpiG1, true>(lds, (const bf16*)(ws + WS_H), (const bf16*)(ws + WS_WT_IN), 4864, DM, E);
}
DI void phase_g3(const Params& P, char* lds) {
  char* ws = P.ws;
  EpiG3 E{(bf16*)(ws + WS_QA), (bf16*)P.out, (const bf16*)P.out + (size_t)M * DM, P.dn_norm, (float*)(lds + XCH_OFF), (const bf16*)(ws + WS_PB), (const float*)(ws + WS_ML)};
  run_gemm<EpiG3, true>(lds, (const bf16*)(ws + WS_H), (const bf16*)(ws + WS_WT_IN) + (size_t)R_G3 * DM, 2048, DM, E);
}
struct ChainOrder4 {
  pg8::StaticOrder so; const char* ws; const char* out;
  DI bool next(int i, pg8::Unit& u) const { if (!so.next(i >> 2, u)) return false; u.kind = i & 3; return true; }
  DI void ab(const pg8::Gemm&, const pg8::Unit& u, size_t tstep, const char*& A, const char*& B) const {
    size_t oa = WS_H; if (u.kind == 1) oa = WS_QA;
    size_t ob = WS_WT_IN + (size_t)R_GA * DM * 2; if (u.kind == 1) ob = WS_WT_BRA; if (u.kind == 2) ob = WS_WT_IN + (size_t)R_GD * DM * 2; if (u.kind == 3) ob = WS_WT_BRD;
    const char* a = ws + oa; if (u.kind == 3) a = out;
    A = a + (size_t)u.pm * tstep; B = ws + ob + (size_t)u.pn * tstep;
  }
  DI void a_ready(const pg8::Unit&) const {}
  DI void done(const pg8::Unit&) const {}
};
struct EpiG4 {
  static constexpr bool PERM = true, AFTER_DRAIN = false;
  bf16* T1; bf16* MX;
  DI void operator()(const pg8::f32x4 (&acc)[2][2][4][2], const pg8::Unit& u, int wr, int wc, int fr, int fq) const {
    const int row0 = u.pm * 256 + wr * 64 + fr, c0 = u.pn * 256 + wc * 32 + fq * 8, kind = u.kind;
#pragma unroll
    for (int ai = 0; ai < 2; ++ai)
#pragma unroll
      for (int m = 0; m < 4; ++m) {
#pragma unroll
        for (int bj = 0; bj < 2; ++bj) {
          const size_t idx = (size_t)(row0 + ai * 128 + m * 16) * 1024 + bj * 128 + c0;
          const pg8::f32x4 a = acc[ai][bj][m][0], b = acc[ai][bj][m][1];
          float v[8] = {a[0], a[1], a[2], a[3], b[0], b[1], b[2], b[3]};
          if ((kind & 1) == 0) {
#pragma unroll
            for (int e = 0; e < 8; ++e) v[e] = sigmoidf_(v[e]);
            *(u32x4*)(T1 + idx) = pack8(v);
          } else {
            float g[8]; unpack8(*(const u32x4*)(T1 + idx), g);
#pragma unroll
            for (int e = 0; e < 8; ++e) v[e] *= g[e];
            if (kind == 3) { float p[8]; unpack8(*(const u32x4*)(MX + idx), p);
#pragma unroll
              for (int e = 0; e < 8; ++e) v[e] += p[e]; }
            *(u32x4*)(MX + idx) = pack8(v);
          }
        }
        asm volatile("" ::: "memory");
      }
  }
};
DI void phase_g4(const Params& P, char* lds) {
  char* ws = P.ws;
  const bf16* WT = (const bf16*)(ws + WS_WT_IN);
  ChainOrder4 S; S.so.init(M, 1024, (int)gridDim.x, (int)blockIdx.x);
  S.ws = ws; S.out = (const char*)P.out;
  EpiG4 E{(bf16*)(ws + WS_X1B), (bf16*)(ws + WS_MIXIN)};
  pg8::Gemm g{(const bf16*)(ws + WS_H), WT + (size_t)R_GA * DM, M, 1024, DM};
  pg8::gemm_phase<EpiG4, ChainOrder4, true, true>((PG8_LAS unsigned char*)lds, g, S, E);
}
DI void phase_g5(const Params& P, char* lds) {
  char* ws = P.ws;
  EpiEW<4> E{(bf16*)(ws + WS_MIXO), nullptr, nullptr};
  run_gemm<EpiEW<4>, true>(lds, (const bf16*)(ws + WS_MIXIN), (const bf16*)(ws + WS_WT_OUT), 1024, DM, E);
}
DI void phase_g6(const Params& P, char* lds) {
  char* ws = P.ws;
  bf16* T1 = (bf16*)(ws + WS_MIXIN);
  { EpiEW<4> E{T1, nullptr, nullptr}; run_gemm<EpiEW<4>, true>(lds, (const bf16*)(ws + WS_PB), (const bf16*)(ws + WS_WT_PP), 1024, PLE, E); }
  { EpiEW<6> E{(bf16*)(ws + WS_MIXO), nullptr, T1}; run_gemm<EpiEW<6>, true>(lds, (const bf16*)(ws + WS_X1B), (const bf16*)(ws + WS_WT_PG), 1024, DM, E); }
}

DI bf16x8 ldfragP(const char* base, int stride, int row, int kbase, int hi) {
  const char* p = base + row * stride + (kbase + 4 * hi) * 2;
  const s16x4 lo = *(const s16x4*)p, h4 = *(const s16x4*)(p + 16);
  return __builtin_shufflevector(lo, h4, 0, 1, 2, 3, 4, 5, 6, 7);
}
template <int S> DI bf16x8 packacc(const f32x16& x) {
  u32x4 w = {pk2(x[8 * S], x[8 * S + 1]), pk2(x[8 * S + 2], x[8 * S + 3]), pk2(x[8 * S + 4], x[8 * S + 5]), pk2(x[8 * S + 6], x[8 * S + 7])};
  return __builtin_bit_cast(bf16x8, w);
}

DI void phase_conv(const Params& P, char* lds) {
  const int tid = threadIdx.x;
  char* ws = P.ws;
  bf16* RAW = (bf16*)(ws + WS_RAW); const bf16* HALO = (const bf16*)(ws + WS_HALO);
  float* ssp = (float*)lds;
  float* srn = (float*)(lds + 8192);
  const int cg = tid % 48, strip = tid / 48;
  const int x = cg >> 4, c8 = (cg & 15) * 8;
  for (int item = blockIdx.x; item < 2048; item += gridDim.x) {
    const int h = item & 7, chunk = item >> 3, n = chunk & 127;
    float y[8][8];
    if (tid < 384) {
      const int col = x * 1024 + h * 128 + c8;
      u32x4 xr[12];
#pragma unroll
      for (int i = 0; i < 12; ++i) {
        const int r = strip * 8 - 2 + i;
        const bf16* src;
        bool ok = true;
        if (r < 0) { ok = n > 0; src = HALO + ((size_t)(chunk - 1) * 4 + 4 + r) * 3072 + col; }
        else if (r >= 64) { ok = n < 127; src = HALO + ((size_t)(chunk + 1) * 4 + (r - 64)) * 3072 + col; }
        else src = RAW + ((size_t)chunk * 64 + r) * 3072 + col;
        xr[i] = ok ? *(const u32x4*)src : u32x4{0u, 0u, 0u, 0u};
      }
#pragma unroll
      for (int rr = 0; rr < 8; ++rr)
#pragma unroll
        for (int e = 0; e < 8; ++e) y[rr][e] = 0.f;
#pragma unroll
      for (int j = 0; j < 5; ++j) {
        const f32x4 wa = *(const f32x4*)(P.conv_w + j * 3072 + col), wb = *(const f32x4*)(P.conv_w + j * 3072 + col + 4);
#pragma unroll
        for (int rr = 0; rr < 8; ++rr) {
          const u32x4 xv = xr[rr + j];
          y[rr][0] += wa[0] * __uint_as_float(xv[0] << 16); y[rr][1] += wa[1] * __uint_as_float(xv[0] & 0xffff0000u);
          y[rr][2] += wa[2] * __uint_as_float(xv[1] << 16); y[rr][3] += wa[3] * __uint_as_float(xv[1] & 0xffff0000u);
          y[rr][4] += wb[0] * __uint_as_float(xv[2] << 16); y[rr][5] += wb[1] * __uint_as_float(xv[2] & 0xffff0000u);
          y[rr][6] += wb[2] * __uint_as_float(xv[3] << 16); y[rr][7] += wb[3] * __uint_as_float(xv[3] & 0xffff0000u);
        }
      }
#pragma unroll
      for (int rr = 0; rr < 8; ++rr) {
        float ss = 0.f;
#pragma unroll
        for (int e = 0; e < 8; ++e) { y[rr][e] = siluf_(y[rr][e]); ss += y[rr][e] * y[rr][e]; }
        if (x < 2) ssp[(x * 64 + strip * 8 + rr) * 16 + (cg & 15)] = ss;
      }
    }
    __syncthreads();
    if (tid < 128) {
      float ss = 0.f;
#pragma unroll
      for (int i = 0; i < 16; ++i) ss += ssp[tid * 16 + i];
      srn[tid] = rsqrtf(ss + EPS) * (tid < 64 ? 0.08838834764831845f : 1.f);
    }
    __syncthreads();
    if (tid < 384) {
      const int col = x * 1024 + h * 128 + c8;
#pragma unroll
      for (int rr = 0; rr < 8; ++rr) {
        const int row = strip * 8 + rr;
        const float sc = x < 2 ? srn[x * 64 + row] : 1.f;
        u32x4 o = {pk2(y[rr][0] * sc, y[rr][1] * sc), pk2(y[rr][2] * sc, y[rr][3] * sc), pk2(y[rr][4] * sc, y[rr][5] * sc), pk2(y[rr][6] * sc, y[rr][7] * sc)};
        *(u32x4*)(RAW + ((size_t)chunk * 64 + row) * 3072 + col) = o;
      }
    }
    __syncthreads();
  }
}

constexpr int D1_WAVE_LDS = 17408;
DI void phase_d1(const Params& P, char* lds) {
  const int tid = threadIdx.x, lane = tid & 63, r32 = lane & 31, hi = lane >> 5;
  const int wave = __builtin_amdgcn_readfirstlane(tid >> 6);
  char* ws = P.ws;
  const bf16* RAW = (const bf16*)(ws + WS_RAW); const float* GB = (const float*)(ws + WS_GB); bf16* TM = (bf16*)(ws + WS_TM);
  char* wl = lds + wave * D1_WAVE_LDS;
  float* sG = (float*)(wl + 16896); float* sB = sG + 64;
  for (int item = blockIdx.x * 8 + wave; item < 4096; item += gridDim.x * 8) {
    const int n = item & 127, dir = (item >> 7) & 1, h = (item >> 8) & 7, b = item >> 11;
    const int pos = n * 64 + lane, t = dir ? (SEQ - 1 - pos) : pos;
    const size_t m = (size_t)b * SEQ + t;
    const float beta = GB[m * 32 + dir * 8 + h];
    float G = GB[m * 32 + 16 + dir * 8 + h];
#pragma unroll
    for (int o = 1; o < 64; o <<= 1) { const float v = __shfl_up(G, o); if (lane >= o) G += v; }
    { const bf16* rk = RAW + m * 3072 + 1024 + h * 128;
#pragma unroll
      for (int ch = 0; ch < 16; ++ch) {
        const u32x4 xv = *(const u32x4*)(rk + ch * 8);
        *(u32x2*)(wl + lane * 264 + ch * 16) = u32x2{xv[0], xv[1]}; *(u32x2*)(wl + lane * 264 + ch * 16 + 8) = u32x2{xv[2], xv[3]};
      } }
    sG[lane] = G; sB[lane] = beta;
    ((float*)(ws + WS_GC))[(size_t)item * 64 + lane] = G;
    f32x16 c00 = {}, c10 = {}, c11 = {};
#pragma unroll
    for (int s = 0; s < 8; ++s) {
      const bf16x8 f0 = ldfragP(wl, 264, r32, s * 16, hi), f1 = ldfragP(wl, 264, 32 + r32, s * 16, hi);
      c00 = MFMA(f0, f0, c00); c10 = MFMA(f1, f0, c10); c11 = MFMA(f1, f1, c11);
    }
    float* L = (float*)wl;
    { const float Gj0 = sG[r32], Gj1 = sG[32 + r32];
      const float* sG4 = sG + 4 * hi; const float* sB4 = sB + 4 * hi; float* L4 = L + (4 * hi) * 64 + r32;
#pragma unroll
      for (int r = 0; r < 16; ++r) {
        const float bi0 = sB4[CRC(r)], bi1 = sB4[32 + CRC(r)], Gi0 = sG4[CRC(r)], Gi1 = sG4[32 + CRC(r)];
        const float l00 = (r32 < 4 * hi + CRC(r)) ? bi0 * c00[r] * __expf(Gi0 - Gj0) : 0.f;
        const float l10 = bi1 * c10[r] * __expf(Gi1 - Gj0);
        const float l11 = (r32 < 4 * hi + CRC(r)) ? bi1 * c11[r] * __expf(Gi1 - Gj1) : 0.f;
        L4[CRC(r) * 64] = l00; L4[(32 + CRC(r)) * 64] = l10; L4[(32 + CRC(r)) * 64 + 32] = l11;
      } }
    float tc[64];
#pragma unroll
    for (int i = 0; i < 64; ++i) {
      float a = (lane == i) ? 1.f : 0.f;
#pragma unroll
      for (int j4 = 0; j4 < (i + 3) / 4; ++j4) {
        const f32x4 l = *(const f32x4*)(L + i * 64 + j4 * 4);
#pragma unroll
        for (int e = 0; e < 4; ++e) if (j4 * 4 + e < i) a -= l[e] * tc[j4 * 4 + e];
      }
      tc[i] = a;
    }
    bf16* To = TM + (size_t)item * 4096;
#pragma unroll
    for (int i = 0; i < 64; ++i) To[i * 64 + lane] = f2bf(tc[i]);
  }
}

constexpr int SB_QH = 0, SB_KH = 16896, SB_VV = 33792, SB_TT = 50176, SB_G = 58880, SB_B = 59136, SB_E1 = 59392, SB_E2 = 59648, SB_SIZE = 59904, SC_AQ = 2 * SB_SIZE;
typedef __attribute__((address_space(3))) const char* lds_cptr;
typedef short v4i16_t __attribute__((ext_vector_type(4)));
DI s16x4 vtr(lds_cptr p) { return __builtin_bit_cast(s16x4, __builtin_amdgcn_ds_read_tr16_b64_v4i16((__attribute__((address_space(3))) v4i16_t*)p)); }
DI bf16x8 ldfragT(lds_cptr tp) { const s16x4 lo = vtr(tp), h4 = vtr(tp + 8 * 264); return __builtin_shufflevector(lo, h4, 0, 1, 2, 3, 4, 5, 6, 7); }

DI void delta_chain(const Params& P, char* lds, int chain) {
  int tid_ = threadIdx.x; asm volatile("" : "+v"(tid_));
  const int tid = tid_, lane = tid & 63, r32 = lane & 31, hi = lane >> 5;
  const int wave = __builtin_amdgcn_readfirstlane(tid >> 6);
  const int dir = chain & 1, h = (chain >> 1) & 7, b = chain >> 4;
  char* ws = P.ws;
  const bf16* RAW = (const bf16*)(ws + WS_RAW) + (size_t)b * SEQ * 3072 + h * 128;
  const float* GB = (const float*)(ws + WS_GB) + (size_t)b * SEQ * 32;
  const float* GC = (const float*)(ws + WS_GC) + (size_t)chain * 128 * 64;
  const bf16* TM = (const bf16*)(ws + WS_TM) + (size_t)chain * 128 * 4096;
  bf16* OD = (bf16*)P.out + (size_t)dir * M * DM + (size_t)b * SEQ * DM + h * 128;
  __syncthreads();
  if (wave >= 4) {
    const int lt = tid - 256;
    u32x4 rq[4], rk[4], rv[4], rt[2]; float rg = 0.f, rb = 0.f;
#define L_LOAD(n) do { _Pragma("unroll") for (int i = 0; i < 4; ++i) { const int id = lt + 256 * i, row = id >> 4, ck = id & 15; \
        const int pos = (n) * 64 + row, t = dir ? (SEQ - 1 - pos) : pos; const bf16* src = RAW + (size_t)t * 3072 + ck * 8; \
        rq[i] = *(const u32x4*)src; rk[i] = *(const u32x4*)(src + 1024); rv[i] = *(const u32x4*)(src + 2048); } \
      _Pragma("unroll") for (int i = 0; i < 2; ++i) rt[i] = *(const u32x4*)(TM + (size_t)(n) * 4096 + (lt + 256 * i) * 8); \
      if (lt < 64) { const int pos = (n) * 64 + lt, t = dir ? (SEQ - 1 - pos) : pos; rg = GC[(n) * 64 + lt]; rb = GB[(size_t)t * 32 + dir * 8 + h]; } } while (0)
#define L_STORE(bf) do { char* bb = lds + (bf) * SB_SIZE; _Pragma("unroll") for (int i = 0; i < 4; ++i) { const int id = lt + 256 * i, row = id >> 4, ck = id & 15; \
        *(u32x2*)(bb + SB_QH + row * 264 + ck * 16) = u32x2{rq[i][0], rq[i][1]}; *(u32x2*)(bb + SB_QH + row * 264 + ck * 16 + 8) = u32x2{rq[i][2], rq[i][3]}; \
        *(u32x2*)(bb + SB_KH + row * 264 + ck * 16) = u32x2{rk[i][0], rk[i][1]}; *(u32x2*)(bb + SB_KH + row * 264 + ck * 16 + 8) = u32x2{rk[i][2], rk[i][3]}; \
        *(u32x4*)(bb + SB_VV + row * 256 + ck * 16) = rv[i]; } \
      _Pragma("unroll") for (int i = 0; i < 2; ++i) { const int id = lt + 256 * i, row = id >> 3, ck = id & 7; \
        *(u32x2*)(bb + SB_TT + row * 136 + ck * 16) = u32x2{rt[i][0], rt[i][1]}; *(u32x2*)(bb + SB_TT + row * 136 + ck * 16 + 8) = u32x2{rt[i][2], rt[i][3]}; } \
      if (lt < 64) { ((float*)(bb + SB_G))[lt] = rg; ((float*)(bb + SB_B))[lt] = rb; ((float*)(bb + SB_E1))[lt] = __expf(rg); ((float*)(bb + SB_E2))[lt] = __expf(__shfl(rg, 63) - rg); } } while (0)
    L_LOAD(0); L_STORE(0); L_LOAD(1);
    const int bi = (wave == 4 || wave == 7) ? 0 : 1, bj = (wave == 6 || wave == 7) ? 1 : 0;
    for (int n = 0; n < 128; ++n) {
      const int cur = n & 1;
      __syncthreads();
      { const char* bb = lds + cur * SB_SIZE; const float* sG = (const float*)(bb + SB_G);
        f32x16 a = {};
        if (wave != 7) {
#pragma unroll
          for (int s = 0; s < 8; ++s) a = MFMA(ldfragP(bb + SB_QH, 264, 32 * bi + r32, s * 16, hi), ldfragP(bb + SB_KH, 264, 32 * bj + r32, s * 16, hi), a);
        }
        const int j = 32 * bj + r32; const float Gj = sG[j];
        const int ib = 32 * bi + 4 * hi;
        const float* sGi = sG + ib; char* aqb = lds + SC_AQ + ib * 136 + j * 2;
#pragma unroll
        for (int r = 0; r < 16; ++r) {
          const float v = (wave != 7 && j <= ib + CRC(r)) ? a[r] * __expf(sGi[CRC(r)] - Gj) : 0.f;
          *(bf16*)(aqb + CRC(r) * 136) = f2bf(v);
        } }
      __syncthreads();
      if (n + 1 < 128) L_STORE(cur ^ 1);
      if (n + 2 < 128) L_LOAD(n + 2);
    }
#undef L_LOAD
#undef L_STORE
  } else {
    f32x16 S0 = {}, S1 = {}, S2 = {}, S3 = {};
    const int g16 = (lane >> 4) & 1, i16 = lane & 15;
    for (int n = 0; n < 128; ++n) {
      const int cur = n & 1;
      const char* bb = lds + cur * SB_SIZE;
      const float* sB4 = (const float*)(bb + SB_B) + 4 * hi; const float* sE14 = (const float*)(bb + SB_E1) + 4 * hi; const float* sE24 = (const float*)(bb + SB_E2) + 4 * hi;
      __syncthreads();
      f32x16 o0 = {}, o1 = {};
      bf16x8 vp00, vp01, vp10, vp11, vd00, vd01, vd10, vd11;
      {
        const bf16x8 sp00 = packacc<0>(S0), sp01 = packacc<1>(S0), sp10 = packacc<0>(S1), sp11 = packacc<1>(S1);
        const bf16x8 sp20 = packacc<0>(S2), sp21 = packacc<1>(S2), sp30 = packacc<0>(S3), sp31 = packacc<1>(S3);
        f32x16 k0 = {}, k1 = {};
#define KQ_STEP(TILE, A0, A1, DB, SS, SP) do { A0 = MFMA(ldfragP(bb + TILE, 264, r32, 32 * DB + 16 * SS, hi), SP, A0); \
                                              A1 = MFMA(ldfragP(bb + TILE, 264, 32 + r32, 32 * DB + 16 * SS, hi), SP, A1); } while (0)
        KQ_STEP(SB_KH, k0, k1, 0, 0, sp00); KQ_STEP(SB_KH, k0, k1, 0, 1, sp01); KQ_STEP(SB_KH, k0, k1, 1, 0, sp10); KQ_STEP(SB_KH, k0, k1, 1, 1, sp11);
        KQ_STEP(SB_KH, k0, k1, 2, 0, sp20); KQ_STEP(SB_KH, k0, k1, 2, 1, sp21); KQ_STEP(SB_KH, k0, k1, 3, 0, sp30); KQ_STEP(SB_KH, k0, k1, 3, 1, sp31);
        { const char* vvb = bb + SB_VV + (4 * hi) * 256 + (32 * wave + r32) * 2;
#pragma unroll
          for (int r = 0; r < 16; ++r) {
            k0[r] = sB4[CRC(r)] * (bf2f(*(const bf16*)(vvb + CRC(r) * 256)) - sE14[CRC(r)] * k0[r]);
            k1[r] = sB4[32 + CRC(r)] * (bf2f(*(const bf16*)(vvb + (32 + CRC(r)) * 256)) - sE14[32 + CRC(r)] * k1[r]);
          } }
        const bf16x8 rp00 = packacc<0>(k0), rp01 = packacc<1>(k0), rp10 = packacc<0>(k1), rp11 = packacc<1>(k1);
        f32x16 v0 = {}, v1 = {};
#define T_STEP(MB, SS, RP) do { v0 = MFMA(ldfragP(bb + SB_TT, 136, r32, 32 * MB + 16 * SS, hi), RP, v0); \
                                v1 = MFMA(ldfragP(bb + SB_TT, 136, 32 + r32, 32 * MB + 16 * SS, hi), RP, v1); } while (0)
        T_STEP(0, 0, rp00); T_STEP(0, 1, rp01); T_STEP(1, 0, rp10); T_STEP(1, 1, rp11);
        vp00 = packacc<0>(v0); vp01 = packacc<1>(v0); vp10 = packacc<0>(v1); vp11 = packacc<1>(v1);
#pragma unroll
        for (int r = 0; r < 16; ++r) { v0[r] *= sE24[CRC(r)]; v1[r] *= sE24[32 + CRC(r)]; }
        vd00 = packacc<0>(v0); vd01 = packacc<1>(v0); vd10 = packacc<0>(v1); vd11 = packacc<1>(v1);
        __builtin_amdgcn_sched_barrier(0);
        KQ_STEP(SB_QH, o0, o1, 0, 0, sp00); KQ_STEP(SB_QH, o0, o1, 0, 1, sp01); KQ_STEP(SB_QH, o0, o1, 1, 0, sp10); KQ_STEP(SB_QH, o0, o1, 1, 1, sp11);
        KQ_STEP(SB_QH, o0, o1, 2, 0, sp20); KQ_STEP(SB_QH, o0, o1, 2, 1, sp21); KQ_STEP(SB_QH, o0, o1, 3, 0, sp30); KQ_STEP(SB_QH, o0, o1, 3, 1, sp31);
#pragma unroll
        for (int r = 0; r < 16; ++r) { o0[r] *= sE14[CRC(r)]; o1[r] *= sE14[32 + CRC(r)]; }
      }
      __syncthreads();
#define A_STEP(MB, SS, VP) do { o0 = MFMA(ldfragP(lds + SC_AQ, 136, r32, 32 * MB + 16 * SS, hi), VP, o0); \
                                o1 = MFMA(ldfragP(lds + SC_AQ, 136, 32 + r32, 32 * MB + 16 * SS, hi), VP, o1); } while (0)
      A_STEP(0, 0, vp00); A_STEP(0, 1, vp01); A_STEP(1, 0, vp10); A_STEP(1, 1, vp11);
      { const int pb = n * 64 + 4 * hi, tb = dir ? (SEQ - 1 - pb) : pb;
        bf16* odb = OD + (size_t)tb * DM + 32 * wave + r32;
        const long sgn = dir ? -(long)DM : (long)DM;
#pragma unroll
        for (int r = 0; r < 16; ++r) { odb[sgn * CRC(r)] = (bf16)pk2(o0[r], 0.f); odb[sgn * (32 + CRC(r))] = (bf16)pk2(o1[r], 0.f); } }
      const float eg = ((const float*)(bb + SB_E1))[63];
#pragma unroll
      for (int r = 0; r < 16; ++r) { S0[r] *= eg; S1[r] *= eg; S2[r] *= eg; S3[r] *= eg; }
      { const lds_cptr kt = (lds_cptr)(bb + SB_KH) + (4 * hi + (i16 >> 2)) * 264 + (16 * g16 + 4 * (i16 & 3)) * 2;
#define S_STEP(SX, DB) do { SX = MFMA(ldfragT(kt + (DB) * 64), vd00, SX); SX = MFMA(ldfragT(kt + (DB) * 64 + 16 * 264), vd01, SX); \
                            SX = MFMA(ldfragT(kt + (DB) * 64 + 32 * 264), vd10, SX); SX = MFMA(ldfragT(kt + (DB) * 64 + 48 * 264), vd11, SX); } while (0)
        S_STEP(S0, 0); S_STEP(S1, 1); S_STEP(S2, 2); S_STEP(S3, 3); }
    }
#undef KQ_STEP
#undef T_STEP
#undef A_STEP
#undef S_STEP
  }
  __syncthreads();
}

namespace att {
constexpr int D = 128, NW = 8, QBLK = 32, KVBLK = 64;
constexpr float SCALE = 0.088388347648318440f;
constexpr float THR = 8.f;
constexpr int LDQ = 1024, LDK = 256, LDO = 1024;
constexpr size_t SHM_V = KVBLK * D * 2, SHM_K = KVBLK * D * 2, SHM_ATTN = 2 * SHM_V + 2 * SHM_K + NW * 64 * 4;
using f32x8 = __attribute__((ext_vector_type(8))) float;
#define KSWZ(row, colB) ((row) * 256 + ((colB) ^ (((row) & 7) << 4)))
#define SBAR() __builtin_amdgcn_sched_barrier(0)
DI unsigned cvtpk(float lo, float hi) { unsigned r; asm volatile("v_cvt_pk_bf16_f32 %0, %1, %2" : "=v"(r) : "v"(lo), "v"(hi)); return r; }
DI bf16x8 ld8(const bf16* p) { return *reinterpret_cast<const bf16x8*>(p); }

DI void partialSM(f32x16& p0, f32x16& p1, float mnC) {
  constexpr float C = SCALE * 1.4426950408889634f;
  asm volatile("" : "+v"(p0), "+v"(p1));
  for (int r = 0; r < 16; ++r) p0[r] = fmaf(p0[r], C, mnC); for (int r = 0; r < 16; ++r) p1[r] = fmaf(p1[r], C, mnC);
  for (int r = 0; r < 16; ++r) p0[r] = __builtin_amdgcn_exp2f(p0[r]);
}
DI void finishSM(f32x16& p0, f32x16& p1, float& l_reg, bf16x8& pa0, bf16x8& pa1, bf16x8& pa2, bf16x8& pa3) {
  for (int r = 0; r < 16; ++r) p1[r] = __builtin_amdgcn_exp2f(p1[r]);
  float ps = 0; for (int r = 0; r < 16; ++r) ps += p0[r]; for (int r = 0; r < 16; ++r) ps += p1[r];
  l_reg += ps;
#define PK4(P, BASE, OUT) do { unsigned a0 = cvtpk(P[BASE + 0], P[BASE + 1]), a1 = cvtpk(P[BASE + 2], P[BASE + 3]);   \
    unsigned b0 = cvtpk(P[BASE + 4], P[BASE + 5]), b1 = cvtpk(P[BASE + 6], P[BASE + 7]);                              \
    auto r0 = __builtin_amdgcn_permlane32_swap(a0, b0, false, false); auto r1 = __builtin_amdgcn_permlane32_swap(a1, b1, false, false); \
    u32x4 w = {r0[0], r1[0], r0[1], r1[1]}; OUT = *reinterpret_cast<bf16x8*>(&w); } while (0)
  PK4(p0, 0, pa0); PK4(p0, 8, pa1); PK4(p1, 0, pa2); PK4(p1, 8, pa3);
#undef PK4
}
DI void qkt(f32x16& p0, f32x16& p1, const bf16* Ks, const bf16x8* qr, int r32, int hi) {
  p0 = f32x16{}; p1 = f32x16{};
  for (int d0 = 0; d0 < 8; ++d0) { int cb = (d0 * 16 + hi * 8) * 2;
    bf16x8 b0 = *reinterpret_cast<const bf16x8*>((const char*)Ks + KSWZ(r32, cb));
    bf16x8 b1 = *reinterpret_cast<const bf16x8*>((const char*)Ks + KSWZ(32 + r32, cb));
    p0 = __builtin_amdgcn_mfma_f32_32x32x16_bf16(b0, qr[d0], p0, 0, 0, 0);
    p1 = __builtin_amdgcn_mfma_f32_32x32x16_bf16(b1, qr[d0], p1, 0, 0, 0); }
}
DI int v_st(int k, int c) { const int kk = (k & ~0xC) | ((k & 4) << 1) | ((k & 8) >> 1); return ((kk >> 3) * 4 + (c >> 5)) * 512 + ((kk & 7) * 32 + (c & 31)) * 2; }
DI int v_rd_base(int lane) { return ((lane & 3) << 3) | (((lane >> 2) & 3) << 6) | (((lane >> 4) & 1) << 5) | (((lane >> 5) & 1) << 8); }
constexpr int v_rd_off(int d0, int ks, int half) { return d0 * 512 + ks * 4096 + half * 2048; }
template <int OFF> DI s16x4 tr_read(int vb) {
  s16x4 r; asm volatile("ds_read_b64_tr_b16 %0, %1 offset:%2" : "=&v"(r) : "v"(vb), "i"(OFF) : "memory"); return r;
}
template <int D0> DI void pv_one(f32x16& od, int vb, bf16x8 pa0, bf16x8 pa1, bf16x8 pa2, bf16x8 pa3) {
  const s16x4 l0 = tr_read<v_rd_off(D0, 0, 0)>(vb), h0 = tr_read<v_rd_off(D0, 0, 1)>(vb), l1 = tr_read<v_rd_off(D0, 1, 0)>(vb), h1 = tr_read<v_rd_off(D0, 1, 1)>(vb);
  const s16x4 l2 = tr_read<v_rd_off(D0, 2, 0)>(vb), h2 = tr_read<v_rd_off(D0, 2, 1)>(vb), l3 = tr_read<v_rd_off(D0, 3, 0)>(vb), h3 = tr_read<v_rd_off(D0, 3, 1)>(vb);
  asm volatile("s_waitcnt lgkmcnt(0)" ::: "memory"); SBAR();
#define PK(L, H) (bf16x8){L[0], L[1], L[2], L[3], H[0], H[1], H[2], H[3]}
  od = __builtin_amdgcn_mfma_f32_32x32x16_bf16(pa0, PK(l0, h0), od, 0, 0, 0);
  od = __builtin_amdgcn_mfma_f32_32x32x16_bf16(pa1, PK(l1, h1), od, 0, 0, 0);
  od = __builtin_amdgcn_mfma_f32_32x32x16_bf16(pa2, PK(l2, h2), od, 0, 0, 0);
  od = __builtin_amdgcn_mfma_f32_32x32x16_bf16(pa3, PK(l3, h3), od, 0, 0, 0);
#undef PK
}
template <int D0> DI void pv_sm_one(f32x16& od, int vb, bf16x8 pa0, bf16x8 pa1, bf16x8 pa2, bf16x8 pa3, f32x16& p0, f32x16& p1, float mnC) {
  constexpr float C = SCALE * 1.4426950408889634f;
  const s16x4 l0 = tr_read<v_rd_off(D0, 0, 0)>(vb), h0 = tr_read<v_rd_off(D0, 0, 1)>(vb), l1 = tr_read<v_rd_off(D0, 1, 0)>(vb), h1 = tr_read<v_rd_off(D0, 1, 1)>(vb);
  const s16x4 l2 = tr_read<v_rd_off(D0, 2, 0)>(vb), h2 = tr_read<v_rd_off(D0, 2, 1)>(vb), l3 = tr_read<v_rd_off(D0, 3, 0)>(vb), h3 = tr_read<v_rd_off(D0, 3, 1)>(vb);
  asm volatile("s_waitcnt lgkmcnt(0)" ::: "memory"); SBAR();
#define PK(L, H) (bf16x8){L[0], L[1], L[2], L[3], H[0], H[1], H[2], H[3]}
  od = __builtin_amdgcn_mfma_f32_32x32x16_bf16(pa0, PK(l0, h0), od, 0, 0, 0);
  od = __builtin_amdgcn_mfma_f32_32x32x16_bf16(pa1, PK(l1, h1), od, 0, 0, 0);
#pragma unroll
  for (int r = 4 * D0; r < 4 * D0 + 4; ++r) { p0[r] = __builtin_amdgcn_exp2f(fmaf(p0[r], C, mnC)); p1[r] = fmaf(p1[r], C, mnC); }
  od = __builtin_amdgcn_mfma_f32_32x32x16_bf16(pa2, PK(l2, h2), od, 0, 0, 0);
  od = __builtin_amdgcn_mfma_f32_32x32x16_bf16(pa3, PK(l3, h3), od, 0, 0, 0);
#undef PK
}
DI void pv_sm(f32x16* o, int vb, bf16x8 pa0, bf16x8 pa1, bf16x8 pa2, bf16x8 pa3, f32x16& p0, f32x16& p1, float mnC) {
  pv_sm_one<0>(o[0], vb, pa0, pa1, pa2, pa3, p0, p1, mnC); pv_sm_one<1>(o[1], vb, pa0, pa1, pa2, pa3, p0, p1, mnC);
  pv_sm_one<2>(o[2], vb, pa0, pa1, pa2, pa3, p0, p1, mnC); pv_sm_one<3>(o[3], vb, pa0, pa1, pa2, pa3, p0, p1, mnC);
}
DI void pv_d0(f32x16* o, int vb, bf16x8 pa0, bf16x8 pa1, bf16x8 pa2, bf16x8 pa3) {
  pv_one<0>(o[0], vb, pa0, pa1, pa2, pa3); pv_one<1>(o[1], vb, pa0, pa1, pa2, pa3); pv_one<2>(o[2], vb, pa0, pa1, pa2, pa3); pv_one<3>(o[3], vb, pa0, pa1, pa2, pa3);
}

DI void attn_dense_body(const bf16* Qb, const bf16* __restrict__ Kh, const bf16* __restrict__ Vh, bf16* Ob, int ldo, float* ml, int seq, char* lds, float mnC) {
  constexpr int SDEPTH = 1;
  const int tid = threadIdx.x, wid = tid >> 6, lane = tid & 63, r32 = lane & 31, hi = lane >> 5;
  bf16* V_lds = (bf16*)lds; bf16* K_lds = (bf16*)(lds + 2 * SHM_V);
  float* ws = (float*)(lds + 2 * SHM_V + 2 * SHM_K) + wid * 64; float* li_l = ws; float* al_l = ws + 32;
  float l_reg = 0; f32x16 o[4] = {}; bf16x8 qr[8];
  const bf16* Qw = Qb + (long)(wid * QBLK + r32) * LDQ + hi * 8;
#pragma unroll
  for (int d0 = 0; d0 < 8; ++d0) qr[d0] = ld8(Qw + d0 * 16);
  const int sr = tid >> 4, sc = (tid & 15) * 8, vst0 = v_st(sr, sc), vst1 = v_st(32 + sr, sc);
  const int vb0 = (int)(uintptr_t)V_lds + v_rd_base(lane);
  struct { bf16x8 ks0, ks1; } sr_[SDEPTH];
#define SLOAD(i, k0) do { sr_[i].vs0 = ld8(&Vh[(long)((k0) + sr) * LDK + sc]); sr_[i].vs1 = ld8(&Vh[(long)((k0) + 32 + sr) * LDK + sc]); \
    sr_[i].ks0 = ld8(&Kh[(long)((k0) + sr) * LDK + sc]); sr_[i].ks1 = ld8(&Kh[(long)((k0) + 32 + sr) * LDK + sc]); } while (0)
#define SWRITE(b, i) do { *(bf16x8*)((char*)V_lds + (b) * SHM_V + vst0) = sr_[i].vs0;          \
    *(bf16x8*)((char*)V_lds + (b) * SHM_V + vst1) = sr_[i].vs1; int kc = sc * 2;               \
    *(bf16x8*)((char*)K_lds + (b) * SHM_K + KSWZ(sr, kc)) = sr_[i].ks0;                       \
    *(bf16x8*)((char*)K_lds + (b) * SHM_K + KSWZ(32 + sr, kc)) = sr_[i].ks1; } while (0)
#define SWAIT() do { asm volatile("s_waitcnt vmcnt(0)" ::: "memory"); } while (0)
  f32x16 pA0, pA1, pB0, pB1; bf16x8 pa0, pa1, pa2, pa3; const int NT = seq / KVBLK;
#define LOADK(k0) do { sr_[0].ks0 = ld8(&Kh[(long)((k0) + sr) * LDK + sc]); sr_[0].ks1 = ld8(&Kh[(long)((k0) + 32 + sr) * LDK + sc]); } while (0)
#define LOADV(k0) do { sr_[0].ks0 = ld8(&Vh[(long)((k0) + sr) * LDK + sc]); sr_[0].ks1 = ld8(&Vh[(long)((k0) + 32 + sr) * LDK + sc]); } while (0)
#define WRITEK(b) do { const int kc = sc * 2; *(bf16x8*)((char*)K_lds + (b) * SHM_K + KSWZ(sr, kc)) = sr_[0].ks0; *(bf16x8*)((char*)K_lds + (b) * SHM_K + KSWZ(32 + sr, kc)) = sr_[0].ks1; } while (0)
#define WRITEV(b) do { *(bf16x8*)((char*)V_lds + (b) * SHM_V + vst0) = sr_[0].ks0; *(bf16x8*)((char*)V_lds + (b) * SHM_V + vst1) = sr_[0].ks1; } while (0)
  {
    const bf16x8 a0 = ld8(&Kh[(long)sr * LDK + sc]), a1 = ld8(&Kh[(long)(32 + sr) * LDK + sc]);
    const bf16x8 b0 = ld8(&Vh[(long)sr * LDK + sc]), b1 = ld8(&Vh[(long)(32 + sr) * LDK + sc]);
    const bf16x8 c0 = ld8(&Kh[(long)(KVBLK + sr) * LDK + sc]), c1 = ld8(&Kh[(long)(KVBLK + 32 + sr) * LDK + sc]);
    LOADV(KVBLK);
    const int kc = sc * 2;
    *(bf16x8*)((char*)K_lds + KSWZ(sr, kc)) = a0; *(bf16x8*)((char*)K_lds + KSWZ(32 + sr, kc)) = a1;
    *(bf16x8*)((char*)V_lds + vst0) = b0; *(bf16x8*)((char*)V_lds + vst1) = b1;
    *(bf16x8*)((char*)K_lds + SHM_K + KSWZ(sr, kc)) = c0; *(bf16x8*)((char*)K_lds + SHM_K + KSWZ(32 + sr, kc)) = c1;
    __syncthreads(); }
  qkt(pA0, pA1, K_lds, qr, r32, hi); partialSM(pA0, pA1, mnC);
  for (int j = 1; j + 1 < NT; j += 2) {
    SBAR(); qkt(pB0, pB1, (bf16*)((char*)K_lds + SHM_K), qr, r32, hi);
    SWAIT(); WRITEV(1); LOADK((j + 1) * KVBLK);
    finishSM(pA0, pA1, l_reg, pa0, pa1, pa2, pa3); SBAR();
    pv_sm(o, vb0, pa0, pa1, pa2, pa3, pB0, pB1, mnC);
    SWAIT(); WRITEK(0); LOADV((j + 1) * KVBLK); __syncthreads();
    SBAR(); qkt(pA0, pA1, K_lds, qr, r32, hi);
    SWAIT(); WRITEV(0); LOADK((j + 2) * KVBLK);
    finishSM(pB0, pB1, l_reg, pa0, pa1, pa2, pa3); SBAR();
    pv_sm(o, vb0 + (int)SHM_V, pa0, pa1, pa2, pa3, pA0, pA1, mnC);
    SWAIT(); WRITEK(1); LOADV((j + 2) * KVBLK); __syncthreads();
  }
  SBAR(); qkt(pB0, pB1, (bf16*)((char*)K_lds + SHM_K), qr, r32, hi);
  finishSM(pA0, pA1, l_reg, pa0, pa1, pa2, pa3); SBAR();
  pv_sm(o, vb0, pa0, pa1, pa2, pa3, pB0, pB1, mnC);
  SWAIT(); WRITEV(1); __syncthreads();
  finishSM(pB0, pB1, l_reg, pa0, pa1, pa2, pa3); SBAR();
  pv_d0(o, vb0 + (int)SHM_V, pa0, pa1, pa2, pa3);
#undef LOADK
#undef LOADV
#undef WRITEK
#undef WRITEV
  { auto rr = __builtin_amdgcn_permlane32_swap(__float_as_uint(l_reg), __float_as_uint(l_reg), false, false); l_reg = __uint_as_float(rr[0]) + __uint_as_float(rr[1]); }
  if (hi == 0) { li_l[r32] = l_reg; if (ml) { ml[(wid * QBLK + r32) * 2] = 0.f; ml[(wid * QBLK + r32) * 2 + 1] = l_reg; } }
  asm volatile("s_waitcnt lgkmcnt(0)" ::: "memory");
  float rli[16];
#pragma unroll
  for (int r = 0; r < 16; ++r) rli[r] = __builtin_amdgcn_rcpf(li_l[crow(r, hi)]);
  bf16* Ow = Ob + (long)(wid * QBLK) * ldo;
#pragma unroll
  for (int r = 0; r < 16; ++r) { int orow = crow(r, hi);
    for (int d0 = 0; d0 < 4; ++d0) Ow[(long)orow * ldo + d0 * 32 + r32] = f2bf(o[d0][r] * rli[r]); }
#undef SLOAD
#undef SWRITE
#undef SWAIT
#undef RESC
}
}

DI void phase_mix(const Params& P, char* lds) {
  char* ws = P.ws;
#ifndef NO_DELTA
  for (int chain = blockIdx.x; chain < 32; chain += gridDim.x) delta_chain(P, lds, chain);
#endif
  unsigned* counter = (unsigned*)(ws + WS_MISC + 65536);
  volatile int* su = (volatile int*)(lds + LDS_BYTES - 16);
  bf16* QA = (bf16*)(ws + WS_QA); const bf16* KA = (const bf16*)(ws + WS_KA); const bf16* VA = (const bf16*)(ws + WS_VA);
  float gq, gk;
  { const int ln = threadIdx.x & 63;
    gq = fmaxf(fabsf(P.q_norm[ln]), fabsf(P.q_norm[ln + 64])); gk = fmaxf(fabsf(P.k_norm[ln]), fabsf(P.k_norm[ln + 64]));
    for (int o = 32; o > 0; o >>= 1) { gq = fmaxf(gq, __shfl_xor(gq, o)); gk = fmaxf(gk, __shfl_xor(gk, o)); } }
  const float mnC = -(gq * gk * 11.313708499f * 1.02f + 0.1f) * 1.4426950408889634f;
  if (threadIdx.x == 0) *su = (int)atomicAdd(counter, 1u);
  __syncthreads();
  for (;;) {
    const int it = *su;
    if (it >= 704) break;
    int nxt = -1;
    if (threadIdx.x == 0 && it < 448) nxt = (int)atomicAdd(counter, 1u);
    const int u = it < 448 ? it : 448 + ((it - 448) >> 2), qtr = (it - 448) & 3;
    const int qb = u & 31, hq = (u >> 5) & 7, b = u >> 8, kvh = hq >> 2;
    bf16* q0 = QA + ((size_t)b * SEQ + qb * 256) * 1024 + hq * 128;
    const bf16* k0 = KA + (size_t)b * SEQ * 256 + kvh * 128;
    const bf16* v0 = VA + (size_t)b * SEQ * 256 + kvh * 128;
    if (it < 448) att::attn_dense_body(q0, k0, v0, q0, 1024, nullptr, SEQ, lds, mnC);
    else {
      const int pc = it - 448;
      att::attn_dense_body(q0, k0 + (size_t)qtr * 2048 * 256, v0 + (size_t)qtr * 2048 * 256, (bf16*)(ws + WS_PB) + (size_t)pc * 256 * 128, 128, (float*)(ws + WS_ML) + (size_t)pc * 512, 2048, lds, mnC);
    }
    __syncthreads();
    if (threadIdx.x == 0) *su = nxt >= 0 ? nxt : (int)atomicAdd(counter, 1u);
    __syncthreads();
  }
}

DI void phase_rownorm(const float* __restrict__ base, const bf16* __restrict__ src, const float* __restrict__ w, float* dst, bf16* dstb) {
  const int tid = threadIdx.x, wave = tid >> 6, lane = tid & 63;
  for (int row = blockIdx.x * 8 + wave; row < M; row += gridDim.x * 8) {
    const size_t ro = (size_t)row * DM;
    f32x4 v[4]; float ss = 0.f;
#pragma unroll
    for (int i = 0; i < 4; ++i) { const u32x2 sv = *(const u32x2*)(src + ro + i * 256 + lane * 4);
      v[i] = f32x4{__uint_as_float(sv[0] << 16), __uint_as_float(sv[0] & 0xffff0000u), __uint_as_float(sv[1] << 16), __uint_as_float(sv[1] & 0xffff0000u)};
      ss += v[i][0] * v[i][0] + v[i][1] * v[i][1] + v[i][2] * v[i][2] + v[i][3] * v[i][3]; }
    ss = wave_sum(ss);
    const float rstd = rsqrtf(ss * (1.f / DM) + EPS);
#pragma unroll
    for (int i = 0; i < 4; ++i) {
      const f32x4 ww = *(const f32x4*)(w + i * 256 + lane * 4);
      const f32x4 bb = *(const f32x4*)(base + ro + i * 256 + lane * 4);
      f32x4 o;
#pragma unroll
      for (int e = 0; e < 4; ++e) o[e] = bb[e] + v[i][e] * rstd * ww[e];
      *(f32x4*)(dst + ro + i * 256 + lane * 4) = o;
      if (dstb) { u32x2 ob = {pk2(o[0], o[1]), pk2(o[2], o[3])}; *(u32x2*)(dstb + ro + i * 256 + lane * 4) = ob; }
    }
  }
}

#define LAS __attribute__((address_space(3)))
#define XB_TMO      128
#define XB_XCNT(j)  (256  + 64 * (j))
#define XB_XSUB(j)  (1280 + 64 * (j))
#define XB_XGEN(j)  (2304 + 64 * (j))
#define XB_TOP      3328
#define XB_TOPGEN   3392
#define XCD_BAR_WORDS 3456
#define XB_SPIN_CAP (1u << 18)

__device__ __forceinline__ unsigned xb_ld(unsigned* p)              { return __hip_atomic_load(p, __ATOMIC_RELAXED, __HIP_MEMORY_SCOPE_AGENT); }
__device__ __forceinline__ unsigned xb_add(unsigned* p, unsigned v) { return __hip_atomic_fetch_add(p, v, __ATOMIC_RELAXED, __HIP_MEMORY_SCOPE_AGENT); }
__device__ __forceinline__ unsigned xb_xcc_id() { return (unsigned)__builtin_amdgcn_s_getreg((3 << 11) | 20) & 0xFu; }
#define XB_SPIN(cond, bar) do { unsigned _sp = 0; while (cond) { __builtin_amdgcn_s_sleep(1); \
    if ((++_sp & 255u) == 0u) { if (xb_ld(&(bar)[XB_TMO])) break; if (_sp > XB_SPIN_CAP) { atomicAdd(&(bar)[XB_TMO], 1u); break; } } } } while (0)

struct XcdBarrier {
    unsigned* bar; unsigned x;
    volatile LAS unsigned* st;
};

__device__ __forceinline__ XcdBarrier xcd_barrier_post(unsigned* bar, volatile LAS unsigned* st) {
    XcdBarrier b; b.bar = bar; b.x = xb_xcc_id(); b.st = st;
    if (threadIdx.x == 0) (void)xb_add(&bar[XB_XCNT(b.x)], 1u);
    return b;
}
__device__ __forceinline__ void xcd_barrier_complete(unsigned* bar, unsigned x, unsigned& nloc, unsigned& nx) {
    const unsigned G = gridDim.x * gridDim.y * gridDim.z;
    unsigned sum, cnt, mine, sp = 0u;
    for (;;) {
        sum = 0u; cnt = 0u; mine = 0u;
#pragma unroll
        for (unsigned j = 0; j < 16; ++j) { const unsigned c = xb_ld(&bar[XB_XCNT(j)]); sum += c; cnt += (c > 0u) ? 1u : 0u; mine = (j == x) ? c : mine; }
        if (sum == G) break;
        __builtin_amdgcn_s_sleep(1);
        if ((++sp & 255u) == 0u) { if (xb_ld(&bar[XB_TMO])) break; if (sp > XB_SPIN_CAP) { atomicAdd(&bar[XB_TMO], 1u); break; } }
    }
    nloc = mine > 0u ? mine : 1u; nx = cnt > 0u ? cnt : 1u;
}

__device__ __forceinline__ void xcd_barrier(const XcdBarrier& b) {
    asm volatile("s_waitcnt vmcnt(0)" ::: "memory");
    __syncthreads();
    if (threadIdx.x == 0) {
        unsigned* bar = b.bar;
        __builtin_amdgcn_s_waitcnt(0);
        unsigned nloc = b.st[0], nx = b.st[1];
        if (nloc == 0u) { xcd_barrier_complete(bar, b.x, nloc, nx); b.st[0] = nloc; b.st[1] = nx; }
        const unsigned old = xb_add(&bar[XB_XSUB(b.x)], 1u);
        const unsigned gen = old / nloc;
        if (old + 1u == (gen + 1u) * nloc) {
            __builtin_amdgcn_fence(__ATOMIC_RELEASE, "agent");
            asm volatile("s_waitcnt vmcnt(0)" ::: "memory");
            const unsigned og = xb_add(&bar[XB_TOP], 1u);
            const unsigned tg = og / nx;
            if (og + 1u == (tg + 1u) * nx) xb_add(&bar[XB_TOPGEN], 1u);
            else XB_SPIN(xb_ld(&bar[XB_TOPGEN]) == tg, bar);
            __builtin_amdgcn_fence(__ATOMIC_ACQUIRE, "agent");
            xb_add(&bar[XB_XGEN(b.x)], 1u);
            asm volatile("s_waitcnt vmcnt(0)" ::: "memory");
        } else {
            XB_SPIN(xb_ld(&bar[XB_XGEN(b.x)]) == gen, bar);
            __builtin_amdgcn_fence(__ATOMIC_ACQUIRE, "agent");
            asm volatile("s_waitcnt vmcnt(0)" ::: "memory");
        }
    }
    __syncthreads();
}

__global__ void __launch_bounds__(512) mega(Params P) {
  extern __shared__ __attribute__((aligned(16))) char lds[];
  cg::grid_group grid = cg::this_grid();
#ifndef PHMASK
#define PHMASK 0x7ff
#endif
#define PH(k) ((((PHMASK) >> (k)) & 1) && P.ph_lo <= (k) && (k) < P.ph_hi)
  volatile LAS unsigned* bst = (volatile LAS unsigned*)(lds + LDS_BYTES - 32);
  if (threadIdx.x == 0) { bst[0] = 0u; bst[1] = 0u; }
  __syncthreads();
  const XcdBarrier bar = xcd_barrier_post((unsigned*)(P.ws + WS_BAR), bst);
#define SYNC(k) do { if (PH(k) && PH((k) + 1)) xcd_barrier(bar); } while (0)
  if (P.ph_hi > 1000) grid.sync();
  char* ws = P.ws;
  if (PH(0)) phase0(P, lds);
  SYNC(0);
  if (PH(1)) phase_g1(P, lds);
  SYNC(1);
  if (PH(2)) phase_conv(P, lds);
  SYNC(2);
  if (PH(3)) phase_d1(P, lds);
  SYNC(3);
  if (PH(4)) phase_mix(P, lds);
  SYNC(4);
  if (PH(5)) phase_g3(P, lds);
  SYNC(5);
  if (PH(6)) phase_g4(P, lds);
  SYNC(6);
  if (PH(7)) phase_g5(P, lds);
  SYNC(7);
  if (PH(8)) { phase_rownorm(P.x, (const bf16*)(ws + WS_MIXO), P.norm_post, P.out, (bf16*)(ws + WS_X1B)); phase_pconv(P); }
  SYNC(8);
  if (PH(9)) phase_g6(P, lds);
  SYNC(9);
  if (PH(10)) phase_rownorm(P.out, (const bf16*)(ws + WS_MIXO), P.ple_norm, P.out, nullptr);
}

extern "C" void kernel_launch(void* const* d_in, const int* in_sizes, int n_in, void* d_out, int out_size, void* d_ws, size_t ws_size, hipStream_t stream) {
  static int grid_blocks = 0;
  if (grid_blocks == 0) {
    if (n_in != 17 || out_size != M * DM || ws_size < WS_END) { fprintf(stderr, "kernel_launch: unexpected shapes (n_in %d out %d ws %zu)\n", n_in, out_size, ws_size); grid_blocks = -1; return; }
    int dev = 0, cus = 0, per_cu = 0;
    hipGetDevice(&dev);
    hipDeviceGetAttribute(&cus, hipDeviceAttributeMultiprocessorCount, dev);
    if (hipFuncSetAttribute((const void*)mega, hipFuncAttributeMaxDynamicSharedMemorySize, LDS_BYTES) != hipSuccess) { fprintf(stderr, "kernel_launch: hipFuncSetAttribute failed\n"); grid_blocks = -1; return; }
    if (hipOccupancyMaxActiveBlocksPerMultiprocessor(&per_cu, (const void*)mega, 512, LDS_BYTES) != hipSuccess || per_cu < 1) { fprintf(stderr, "kernel_launch: occupancy query gave %d\n", per_cu); per_cu = 1; }
    (void)hipGetLastError();
    grid_blocks = cus * per_cu;
  }
  if (grid_blocks < 0) return;
  Params p{};
  p.x = (const float*)d_in[0]; p.p = (const float*)d_in[1]; p.norm_pre = (const float*)d_in[2]; p.w_in = (const float*)d_in[3];
  p.q_norm = (const float*)d_in[4]; p.k_norm = (const float*)d_in[5]; p.conv_w = (const float*)d_in[6]; p.a_log = (const float*)d_in[7];
  p.dt_bias = (const float*)d_in[8]; p.dn_norm = (const float*)d_in[9]; p.w_br_att = (const float*)d_in[10]; p.w_br_dn = (const float*)d_in[11];
  p.w_out = (const float*)d_in[12]; p.norm_post = (const float*)d_in[13]; p.w_ple_proj = (const float*)d_in[14]; p.w_ple_gate = (const float*)d_in[15];
  p.ple_norm = (const float*)d_in[16];
  p.out = (float*)d_out; p.ws = (char*)d_ws; p.ph_lo = 0; p.ph_hi = 11;
  if (hipMemsetAsync((char*)d_ws + WS_MISC + 65536, 0, 65536 + 16384, stream) != hipSuccess) { fprintf(stderr, "kernel_launch: memset failed\n"); return; }
  void* args[] = {&p};
  hipError_t e = hipLaunchCooperativeKernel((const void*)mega, dim3(grid_blocks), dim3(512), args, LDS_BYTES, stream);
  if (e != hipSuccess) fprintf(stderr, "kernel_launch: cooperative launch failed: %s (grid %d)\n", hipGetErrorString(e), grid_blocks);
}
```

```cpp
#include <hip/hip_runtime.h>
#include <hip/hip_cooperative_groups.h>
#include <cstdio>
#include <cstdint>
namespace cg = cooperative_groups;

using bf16 = unsigned short;
using bf16x8 = __attribute__((ext_vector_type(8))) short;
using s16x4  = __attribute__((ext_vector_type(4))) short;
using f32x16 = __attribute__((ext_vector_type(16))) float;
using f32x4  = __attribute__((ext_vector_type(4))) float;
using u32x4  = __attribute__((ext_vector_type(4))) unsigned;
using u32x2  = __attribute__((ext_vector_type(2))) unsigned;
typedef __bf16 bf16x2_t __attribute__((ext_vector_type(2)));
typedef float f32x2_t __attribute__((ext_vector_type(2)));
#define DI __device__ __forceinline__
#define MFMA(a, b, c) __builtin_amdgcn_mfma_f32_32x32x16_bf16((a), (b), (c), 0, 0, 0)

constexpr int M = 16384, SEQ = 8192, DM = 1024, INW = 8736, PLE = 256;
constexpr int C_AQ = 0, C_AK = 1024, C_AV = 1280, C_AZ = 1536, C_DQ = 2560, C_DB = 5632, C_DZ = 5664, C_GA = 6688, C_GD = 7712;
constexpr float EPS = 1e-6f;
constexpr size_t MiB = 1u << 20;
constexpr size_t WS_WT_IN = 0, WS_WT_BRA = 18 * MiB, WS_WT_BRD = 20 * MiB, WS_WT_OUT = 22 * MiB, WS_WT_PG = 24 * MiB, WS_WT_PP = 26 * MiB;
constexpr size_t WS_BAR = 29 * MiB + 131072;
constexpr size_t WS_ML = 31 * MiB;
constexpr size_t WS_HALO = 248 * MiB;
constexpr size_t WS_GB = 27 * MiB, WS_MISC = 29 * MiB, WS_GC = 30 * MiB;
constexpr size_t WS_H = 32 * MiB, WS_QA = 64 * MiB, WS_KA = 96 * MiB, WS_VA = 104 * MiB, WS_RAW = 112 * MiB, WS_TM = 208 * MiB, WS_PB = 240 * MiB;
constexpr size_t WS_MIXIN = 112 * MiB, WS_MIXO = 144 * MiB, WS_X1B = 208 * MiB, WS_END = 256 * MiB;
constexpr int LDS_BYTES = 141312 + 64;

struct Params {
  const float *x, *p, *norm_pre, *w_in, *q_norm, *k_norm, *conv_w, *a_log, *dt_bias, *dn_norm, *w_br_att, *w_br_dn, *w_out, *norm_post, *w_ple_proj, *w_ple_gate, *ple_norm;
  float* out; char* ws; int ph_lo, ph_hi;
};

DI float bf2f(unsigned short v) { return __uint_as_float(((unsigned)v) << 16); }
DI unsigned short f2bf(float f) { unsigned u = __float_as_uint(f); u += 0x7fffu + ((u >> 16) & 1u); return (unsigned short)(u >> 16); }
DI unsigned pk2(float lo, float hi) { f32x2_t v = {lo, hi}; bf16x2_t b = __builtin_convertvector(v, bf16x2_t); return __builtin_bit_cast(unsigned, b); }
DI int crow(int r, int hi) { return (r & 3) + 8 * (r >> 2) + 4 * hi; }
#define CRC(r) (((r) & 3) + 8 * ((r) >> 2))
DI float wave_sum(float v) { for (int o = 32; o > 0; o >>= 1) v += __shfl_xor(v, o); return v; }
DI float half_sum(float v) { for (int o = 16; o > 0; o >>= 1) v += __shfl_xor(v, o); return v; }
DI float sigmoidf_(float x) { return __builtin_amdgcn_rcpf(1.f + __expf(-x)); }
DI float siluf_(float x) { return x * __builtin_amdgcn_rcpf(1.f + __expf(-x)); }

DI int remap_in(int n) {
  if (n < 1536) return n; if (n < 2560) return n - 1536 + 4864; if (n < 5664) return n - 2560 + 1536; if (n < 6688) return n - 5664 + 5888; return n - 6688 + 6912;
}
template <bool REMAP> DI void transpose_w(const float* __restrict__ W, int K, int N, bf16* __restrict__ WT, float* sl) {
  const int tid = threadIdx.x;
  const int ktiles = K / 64, ntiles = (N + 63) / 64;
  for (int tile = blockIdx.x; tile < ktiles * ntiles; tile += gridDim.x) {
    const int kt = tile % ktiles, nt = tile / ktiles;
#pragma unroll
    for (int i = 0; i < 8; ++i) {
      const int kl = (tid >> 6) + i * 8, nl = tid & 63, n = nt * 64 + nl;
      sl[kl * 65 + nl] = (n < N) ? __builtin_nontemporal_load(W + (size_t)(kt * 64 + kl) * N + n) : 0.f;
    }
    __syncthreads();
    const int nl = tid >> 3, kc = (tid & 7) * 8, n = nt * 64 + nl;
    if (n < N) {
      u32x4 w;
      w[0] = pk2(sl[(kc + 0) * 65 + nl], sl[(kc + 1) * 65 + nl]); w[1] = pk2(sl[(kc + 2) * 65 + nl], sl[(kc + 3) * 65 + nl]);
      w[2] = pk2(sl[(kc + 4) * 65 + nl], sl[(kc + 5) * 65 + nl]); w[3] = pk2(sl[(kc + 6) * 65 + nl], sl[(kc + 7) * 65 + nl]);
      *(u32x4*)(WT + (size_t)(REMAP ? remap_in(n) : n) * K + kt * 64 + kc) = w;
    }
    __syncthreads();
  }
}

DI void phase0(const Params& P, char* lds) {
  const int tid = threadIdx.x, wave = tid >> 6, lane = tid & 63;
  char* ws = P.ws;
  { float2* cs = (float2*)(ws + WS_MISC);
    for (int idx = blockIdx.x * 512 + tid; idx < 4096; idx += gridDim.x * 512) {
      const int pos = idx >> 5, fi = idx & 31;
      const float inv = exp2f(-(float)fi * (13.287712379549449f / 32.f));
      const float ang = (float)pos * inv;
      cs[idx] = make_float2(cosf(ang), sinf(ang));
    } }
  transpose_w<true>(P.w_in, 1024, INW, (bf16*)(ws + WS_WT_IN), (float*)lds);
  transpose_w<false>(P.w_br_att, 1024, 1024, (bf16*)(ws + WS_WT_BRA), (float*)lds);
  transpose_w<false>(P.w_br_dn, 1024, 1024, (bf16*)(ws + WS_WT_BRD), (float*)lds);
  transpose_w<false>(P.w_out, 1024, 1024, (bf16*)(ws + WS_WT_OUT), (float*)lds);
  transpose_w<false>(P.w_ple_gate, 1024, 1024, (bf16*)(ws + WS_WT_PG), (float*)lds);
  transpose_w<false>(P.w_ple_proj, 256, 1024, (bf16*)(ws + WS_WT_PP), (float*)lds);
  bf16* H = (bf16*)(ws + WS_H);
  for (int row = blockIdx.x * 8 + wave; row < M; row += gridDim.x * 8) {
    const float* xr = P.x + (size_t)row * DM;
    f32x4 v[4]; float ss = 0.f;
#pragma unroll
    for (int i = 0; i < 4; ++i) { v[i] = __builtin_nontemporal_load((const f32x4*)(xr + i * 256 + lane * 4)); ss += v[i][0] * v[i][0] + v[i][1] * v[i][1] + v[i][2] * v[i][2] + v[i][3] * v[i][3]; }
    ss = wave_sum(ss);
    const float rstd = rsqrtf(ss * (1.f / DM) + EPS);
#pragma unroll
    for (int i = 0; i < 4; ++i) {
      const f32x4 w = *(const f32x4*)(P.norm_pre + i * 256 + lane * 4);
      u32x2 o = {pk2(v[i][0] * rstd * w[0], v[i][1] * rstd * w[1]), pk2(v[i][2] * rstd * w[2], v[i][3] * rstd * w[3])};
      *(u32x2*)(H + (size_t)row * DM + i * 256 + lane * 4) = o;
    }
  }
}

DI void phase_pconv(const Params& P) {
  const int tid = threadIdx.x; char* ws = P.ws;
  bf16* PB = (bf16*)(ws + WS_PB);
  for (size_t i = (size_t)blockIdx.x * 512 + tid; i < (size_t)M * PLE / 8; i += (size_t)gridDim.x * 512) {
    const f32x4 a = __builtin_nontemporal_load((const f32x4*)(P.p + i * 8)), b = __builtin_nontemporal_load((const f32x4*)(P.p + i * 8 + 4));
    u32x4 o = {pk2(a[0], a[1]), pk2(a[2], a[3]), pk2(b[0], b[1]), pk2(b[2], b[3])};
    *(u32x4*)(PB + i * 8) = o;
  }
}

namespace pg8 {
#define PG8_LAS __attribute__((address_space(3)))
typedef unsigned short bf16_t;
typedef short bf16x8 __attribute__((ext_vector_type(8)));
typedef float f32x4 __attribute__((ext_vector_type(4)));
typedef unsigned u32x4 __attribute__((ext_vector_type(4)));
constexpr int BM = 256, BK = 64, HALF = 128, HTB = HALF * BK * 2  , STAGE_BYTES = 8 * HTB, NXCD = 8, WGM = 8;

__host__ __device__ __forceinline__ int lds_byte(int r, int c) { const int st = (r >> 4) * 2 + (c >> 5), rr = r & 15, cc = c & 31, ob = rr * 64 + cc * 2; return st * 1024 + (ob ^ (((ob >> 9) & 1) << 5)); }
__host__ __device__ __forceinline__ void stage_rc(int b, int& R, int& C) { const int st = b / 1024, sb = b % 1024, swz = sb ^ (((sb >> 9) & 1) << 5); R = (st >> 1) * 16 + swz / 64; C = (st & 1) * 32 + (swz % 64) / 2; }
__host__ __device__ __forceinline__ int perm32(int rho) { const int n = rho >> 4, i = rho & 15; return 8 * (i >> 2) + 4 * n + (i & 3); }

struct Unit { int pm, pn, kind; };
struct Gemm { const bf16_t* A; const bf16_t* Bt; int M, N, K; };

struct StaticOrder {
    int nM, nN, nwg, G, c;
    __host__ __device__ void init(int M, int N, int G_, int c_) { nM = M / BM; nN = N / BM; nwg = nM * nN; G = G_; c = c_; }
    __host__ __device__ bool next(int i, Unit& u) const {
        const long L = (long)i * G + c; if (L >= nwg) return false;
        int wgid = (int)L; { const int q = nwg / NXCD, r = nwg % NXCD, xcd = wgid % NXCD, off = wgid / NXCD; wgid = (xcd < r ? xcd * (q + 1) : r * (q + 1) + (xcd - r) * q) + off; }
        const int nig = WGM * nN, gid = wgid / nig, fm = gid * WGM, gsz = (nM - fm) < WGM ? (nM - fm) : WGM;
        u.pm = fm + ((wgid % nig) % gsz); u.pn = (wgid % nig) / gsz; u.kind = 0; return true;
    }
    __device__ __forceinline__ void ab(const Gemm& g, const Unit& u, size_t tstep, const char*& A, const char*& B) const { A = (const char*)g.A + (size_t)u.pm * tstep; B = (const char*)g.Bt + (size_t)u.pn * tstep; }
    __device__ __forceinline__ void a_ready(const Unit&) const {}
    __device__ __forceinline__ void done(const Unit&) const {}
};
template <class Epi, class Sched, bool ALIGN_EPI = false, bool SP2 = false>
__device__ __forceinline__ void gemm_phase(PG8_LAS unsigned char* lds, const Gemm g, const Sched& S, const Epi& E) {
    const int tid = threadIdx.x, wid = __builtin_amdgcn_readfirstlane(tid >> 6), lane = tid & 63, wr = wid >> 2, wc = wid & 3, fr = lane & 15, fq = lane >> 4;
    const int K = g.K, nt = K / BK;
    unsigned voffA[2], voffB[2];
#pragma unroll
    for (int i = 0; i < 2; ++i) { int R, C; stage_rc(tid * 16 + i * 8192, R, C); const int Rb = Epi::PERM ? ((R & ~31) + perm32(R & 31)) : R;
        voffA[i] = (unsigned)(R * K + C) * 2u; voffB[i] = (unsigned)(Rb * K + C) * 2u; }
    const size_t kstep = (size_t)(BK * 2);
    const size_t hstep = (size_t)HALF * K * 2;
    const size_t tstep = 2 * hstep;
    const unsigned ldsw = (unsigned)wid * 1024u;
    const int aoff = lds_byte(wr * 64 + fr, fq * 8), boff = lds_byte(wc * 32 + fr, fq * 8);
#define PG8_SA(b, h) (((b) * 2 + (h)) * HTB)
#define PG8_SB(b, h) ((4 + (b) * 2 + (h)) * HTB)
#define PG8_STAGE(bufoff, gbase, voff) do { _Pragma("unroll") for (int _i = 0; _i < 2; ++_i) \
        __builtin_amdgcn_global_load_lds((const unsigned*)((const char*)(gbase) + (voff)[_i]), (PG8_LAS unsigned*)(lds + (bufoff) + ldsw + _i * 8192), 16, 0, 0); } while (0)
#define PG8_LDA(dst, b, h) do { _Pragma("unroll") for (int m = 0; m < 4; ++m) _Pragma("unroll") for (int k = 0; k < 2; ++k) dst[m][k] = *(const PG8_LAS bf16x8*)(lds + PG8_SA(b, h) + aoff + m * 2048 + k * 1024); } while (0)
#define PG8_LDB(dst, b, h) do { _Pragma("unroll") for (int n = 0; n < 2; ++n) _Pragma("unroll") for (int k = 0; k < 2; ++k) dst[n][k] = *(const PG8_LAS bf16x8*)(lds + PG8_SB(b, h) + boff + n * 2048 + k * 1024); } while (0)
#define PG8_MMA(ai, bj, At, Bt) do { __builtin_amdgcn_s_setprio(1); _Pragma("unroll") for (int m = 0; m < 4; ++m) _Pragma("unroll") for (int n = 0; n < 2; ++n) _Pragma("unroll") for (int k = 0; k < 2; ++k) \
        acc[ai][bj][m][n] = __builtin_amdgcn_mfma_f32_16x16x32_bf16(Bt[n][k], At[m][k], acc[ai][bj][m][n], 0, 0, 0); __builtin_amdgcn_s_setprio(0); } while (0)
#define PG8_WAIT_V(n) asm volatile("s_waitcnt vmcnt(" #n ")" ::: "memory")
#define PG8_WAIT_L(n) asm volatile("s_waitcnt lgkmcnt(" #n ")" ::: "memory")
#define PG8_BAR __builtin_amdgcn_s_barrier()
#define PG8_SCHED __builtin_amdgcn_sched_barrier(0)
    Unit cur, nxt; int ui = 0;
    if (!S.next(0, cur)) return;
    f32x4 acc[2][2][4][2];
#pragma unroll
    for (int a = 0; a < 2; ++a)
#pragma unroll
        for (int b = 0; b < 2; ++b)
#pragma unroll
            for (int m = 0; m < 4; ++m)
#pragma unroll
                for (int n = 0; n < 2; ++n) acc[a][b][m][n] = (f32x4){0.f, 0.f, 0.f, 0.f};
    bf16x8 At[4][2], B0[2][2], B1[2][2];
    const char* cA; const char* cB; S.ab(g, cur, tstep, cA, cB);
    S.a_ready(cur);
    if constexpr (SP2) {
        PG8_STAGE(PG8_SB(0, 0), cB, voffB); PG8_STAGE(PG8_SB(0, 1), cB + hstep, voffB); PG8_STAGE(PG8_SA(0, 0), cA, voffA); PG8_STAGE(PG8_SA(0, 1), cA + hstep, voffA);
        if (wr == 1) PG8_BAR;
        PG8_WAIT_V(2); PG8_BAR;
        PG8_STAGE(PG8_SB(1, 0), cB + kstep, voffB); PG8_STAGE(PG8_SA(1, 0), cA + kstep, voffA); PG8_STAGE(PG8_SB(1, 1), cB + hstep + kstep, voffB);
        PG8_WAIT_V(6); PG8_BAR;
    } else {
        PG8_STAGE(PG8_SB(0, 0), cB, voffB); PG8_STAGE(PG8_SA(0, 0), cA, voffA); PG8_STAGE(PG8_SB(0, 1), cB + hstep, voffB); PG8_STAGE(PG8_SA(0, 1), cA + hstep, voffA);
        if (wr == 1) PG8_BAR;
        PG8_WAIT_V(4); PG8_BAR;
        PG8_STAGE(PG8_SB(1, 0), cB + kstep, voffB); PG8_STAGE(PG8_SA(1, 0), cA + kstep, voffA); PG8_STAGE(PG8_SB(1, 1), cB + hstep + kstep, voffB);
        PG8_WAIT_V(6); PG8_BAR;
    }
    for (;;) {
        const bool has_next = S.next(ui + 1, nxt);
        const char* nA = cA; const char* nB = cB; if (has_next) S.ab(g, nxt, tstep, nA, nB);
        for (int t = 0; t < nt; t += 2) {
            const bool last = (t == nt - 2);
            const char* a1 = cA + (size_t)(t + 1) * kstep;
            const char* a2 = last ? nA : cA + (size_t)(t + 2) * kstep; const char* b2 = last ? nB : cB + (size_t)(t + 2) * kstep;
            const char* a3 = a2 + kstep; const char* b3 = b2 + kstep;
            if (last && has_next) S.a_ready(nxt);
            if constexpr (SP2) {
            PG8_LDB(B0, 0, 0); PG8_LDB(B1, 0, 1); PG8_SCHED; PG8_LDA(At, 0, 0); PG8_STAGE(PG8_SA(1, 1), a1 + hstep, voffA);
            PG8_WAIT_V(8); PG8_WAIT_L(0); PG8_BAR; PG8_MMA(0, 0, At, B0); PG8_MMA(0, 1, At, B1); PG8_BAR; PG8_SCHED;
            PG8_LDA(At, 0, 1); PG8_STAGE(PG8_SB(0, 0), b2, voffB); PG8_STAGE(PG8_SB(0, 1), b2 + hstep, voffB); PG8_STAGE(PG8_SA(0, 0), a2, voffA);
            PG8_WAIT_V(8); PG8_WAIT_L(0); PG8_BAR; PG8_MMA(1, 0, At, B0); PG8_MMA(1, 1, At, B1); PG8_BAR; PG8_SCHED;
            PG8_LDB(B0, 1, 0); PG8_LDB(B1, 1, 1); PG8_SCHED; PG8_LDA(At, 1, 0); PG8_STAGE(PG8_SA(0, 1), a2 + hstep, voffA);
            PG8_WAIT_V(8); PG8_WAIT_L(0); PG8_BAR; PG8_MMA(0, 0, At, B0); PG8_MMA(0, 1, At, B1); PG8_BAR; PG8_SCHED;
            PG8_LDA(At, 1, 1); PG8_STAGE(PG8_SB(1, 0), b3, voffB); PG8_STAGE(PG8_SB(1, 1), b3 + hstep, voffB); PG8_STAGE(PG8_SA(1, 0), a3, voffA);
            PG8_WAIT_V(8); PG8_WAIT_L(0); PG8_BAR; PG8_MMA(1, 0, At, B0); PG8_MMA(1, 1, At, B1); PG8_BAR; PG8_SCHED;
            } else {
            PG8_LDB(B0, 0, 0); PG8_SCHED; PG8_LDA(At, 0, 0); PG8_STAGE(PG8_SA(1, 1), a1 + hstep, voffA);
            PG8_WAIT_L(8); PG8_BAR; PG8_WAIT_L(0); PG8_MMA(0, 0, At, B0); PG8_BAR; PG8_SCHED;
            PG8_LDB(B1, 0, 1); PG8_STAGE(PG8_SB(0, 0), b2, voffB);
            PG8_BAR; PG8_WAIT_L(0); PG8_MMA(0, 1, At, B1); PG8_BAR;
            PG8_LDA(At, 0, 1); PG8_STAGE(PG8_SA(0, 0), a2, voffA);
            PG8_BAR; PG8_WAIT_L(0); PG8_MMA(1, 0, At, B0); PG8_BAR; PG8_SCHED;
            PG8_STAGE(PG8_SB(0, 1), b2 + hstep, voffB);
            PG8_WAIT_V(6); PG8_BAR; PG8_MMA(1, 1, At, B1); PG8_BAR;
            PG8_LDB(B0, 1, 0); PG8_SCHED; PG8_LDA(At, 1, 0); PG8_STAGE(PG8_SA(0, 1), a2 + hstep, voffA);
            PG8_WAIT_L(8); PG8_BAR; PG8_WAIT_L(0); PG8_MMA(0, 0, At, B0); PG8_BAR; PG8_SCHED;
            PG8_LDB(B1, 1, 1); PG8_STAGE(PG8_SB(1, 0), b3, voffB);
            PG8_BAR; PG8_WAIT_L(0); PG8_MMA(0, 1, At, B1); PG8_BAR;
            PG8_LDA(At, 1, 1); PG8_STAGE(PG8_SA(1, 0), a3, voffA);
            PG8_BAR; PG8_WAIT_L(0); PG8_MMA(1, 0, At, B0); PG8_BAR; PG8_SCHED;
            PG8_STAGE(PG8_SB(1, 1), b3 + hstep, voffB);
            PG8_WAIT_V(6); PG8_BAR; PG8_MMA(1, 1, At, B1); PG8_BAR;
            }
        }
        if constexpr (ALIGN_EPI) { if (wr == 0) PG8_BAR; }
        if constexpr (!Epi::AFTER_DRAIN) { E(acc, cur, wr, wc, fr, fq); S.done(cur); }
        if (!has_next) break;
#pragma unroll
        for (int a = 0; a < 2; ++a)
#pragma unroll
            for (int b = 0; b < 2; ++b)
#pragma unroll
                for (int m = 0; m < 4; ++m)
#pragma unroll
                    for (int n = 0; n < 2; ++n) acc[a][b][m][n] = (f32x4){0.f, 0.f, 0.f, 0.f};
        cur = nxt; cA = nA; cB = nB; ++ui;
        if constexpr (ALIGN_EPI) { if (wr == 1) PG8_BAR; }
    }
    PG8_WAIT_V(0);
    if constexpr (!ALIGN_EPI) { if (wr == 0) PG8_BAR; }
    PG8_BAR;
    if constexpr (Epi::AFTER_DRAIN) { E.fused(acc, cur, wr, wc, fr, fq, lds, wid, lane); S.done(cur); }
#undef PG8_SA
#undef PG8_SB
#undef PG8_STAGE
#undef PG8_LDA
#undef PG8_LDB
#undef PG8_MMA
#undef PG8_WAIT_V
#undef PG8_WAIT_L
#undef PG8_BAR
#undef PG8_SCHED
}


}

constexpr int XCH_OFF = 131072;
DI unsigned lo16f(unsigned w) { return w << 16; }
DI void unpack8(const u32x4 w, float* o) {
#pragma unroll
  for (int e = 0; e < 4; ++e) { o[2 * e] = __uint_as_float(w[e] << 16); o[2 * e + 1] = __uint_as_float(w[e] & 0xffff0000u); }
}
DI u32x4 pack8(const float* v) { return u32x4{pk2(v[0], v[1]), pk2(v[2], v[3]), pk2(v[4], v[5]), pk2(v[6], v[7])}; }
#define XCH_IDX(wr, ai, m, bj, fr) ((((((wr) * 2 + (ai)) * 4 + (m)) * 2 + (bj)) * 16 + (fr)) * 4)

struct EpiG1 {
  static constexpr bool PERM = true, AFTER_DRAIN = false;
  char* ws; const float* q_norm; const float* k_norm; const float* a_log; const float* dt_bias; float* xch;
  DI void operator()(const pg8::f32x4 (&acc)[2][2][4][2], const pg8::Unit& u, int wr, int wc, int fr, int fq) const {
    const int pn = u.pn, row0 = u.pm * 256 + wr * 64 + fr, c0 = wc * 32 + fq * 8;
    if (pn < 5) {
#pragma unroll
      for (int ai = 0; ai < 2; ++ai)
#pragma unroll
        for (int m = 0; m < 4; ++m)
#pragma unroll
          for (int bj = 0; bj < 2; ++bj) {
            const pg8::f32x4 a = acc[ai][bj][m][0], b = acc[ai][bj][m][1];
            float s = a[0] * a[0] + a[1] * a[1] + a[2] * a[2] + a[3] * a[3] + b[0] * b[0] + b[1] * b[1] + b[2] * b[2] + b[3] * b[3];
            s += __shfl_xor(s, 16); s += __shfl_xor(s, 32);
            if (fq == 0) xch[XCH_IDX(wr, ai, m, bj, fr) + wc] = s;
          }
      asm volatile("s_waitcnt lgkmcnt(0)" ::: "memory");
      __builtin_amdgcn_s_barrier();
      const float* nw = pn < 4 ? q_norm : k_norm;
      const f32x4 w0 = *(const f32x4*)(nw + c0), w1 = *(const f32x4*)(nw + c0 + 4);
      const float2* cs = (const float2*)(ws + WS_MISC);
#pragma unroll
      for (int ai = 0; ai < 2; ++ai)
#pragma unroll
        for (int m = 0; m < 4; ++m) {
          const int row = row0 + ai * 128 + m * 16, t = row & (SEQ - 1);
          const int pos = (wc < 2) ? (t >> 6) : (t & 63);
          const float2* cp = cs + pos * 32 + ((c0 >> 1) & 31);
          const f32x4 cs0 = *(const f32x4*)cp, cs1 = *(const f32x4*)(cp + 2);
#pragma unroll
          for (int bj = 0; bj < 2; ++bj) {
            const f32x4 ps = *(const f32x4*)(xch + XCH_IDX(wr, ai, m, bj, fr));
            const float rstd = rsqrtf((ps[0] + ps[1] + ps[2] + ps[3]) * (1.f / 128.f) + EPS);
            const pg8::f32x4 a = acc[ai][bj][m][0], b = acc[ai][bj][m][1];
            float v[8] = {a[0] * rstd * w0[0], a[1] * rstd * w0[1], a[2] * rstd * w0[2], a[3] * rstd * w0[3],
                          b[0] * rstd * w1[0], b[1] * rstd * w1[1], b[2] * rstd * w1[2], b[3] * rstd * w1[3]};
            float o[8];
            o[0] = v[0] * cs0[0] - v[1] * cs0[1]; o[1] = v[0] * cs0[1] + v[1] * cs0[0];
            o[2] = v[2] * cs0[2] - v[3] * cs0[3]; o[3] = v[2] * cs0[3] + v[3] * cs0[2];
            o[4] = v[4] * cs1[0] - v[5] * cs1[1]; o[5] = v[4] * cs1[1] + v[5] * cs1[0];
            o[6] = v[6] * cs1[2] - v[7] * cs1[3]; o[7] = v[6] * cs1[3] + v[7] * cs1[2];
            bf16* dst = pn < 4 ? (bf16*)(ws + WS_QA) + (size_t)row * 1024 + (2 * pn + bj) * 128 + c0 : (bf16*)(ws + WS_KA) + (size_t)row * 256 + bj * 128 + c0;
            *(u32x4*)dst = pack8(o);
          }
          asm volatile("" ::: "memory");
        }
    } else if (pn < 18) {
#pragma unroll
      for (int ai = 0; ai < 2; ++ai)
#pragma unroll
        for (int m = 0; m < 4; ++m) {
          const int row = row0 + ai * 128 + m * 16, c64 = row & 63;
#pragma unroll
          for (int bj = 0; bj < 2; ++bj) {
            const pg8::f32x4 a = acc[ai][bj][m][0], b = acc[ai][bj][m][1];
            const u32x4 w = {pk2(a[0], a[1]), pk2(a[2], a[3]), pk2(b[0], b[1]), pk2(b[2], b[3])};
            if (pn == 5) *(u32x4*)((bf16*)(ws + WS_VA) + (size_t)row * 256 + bj * 128 + c0) = w;
            else {
              const int col = (pn - 6) * 256 + bj * 128 + c0;
              *(u32x4*)((bf16*)(ws + WS_RAW) + (size_t)row * 3072 + col) = w;
              if (c64 < 2 || c64 >= 62) *(u32x4*)((bf16*)(ws + WS_HALO) + ((size_t)(row >> 6) * 4 + (c64 < 2 ? c64 : c64 - 60)) * 3072 + col) = w;
            }
          }
          asm volatile("" ::: "memory");
        }
    } else if (wc == 0) {
      float* GB = (float*)(ws + WS_GB);
      int fqq = fq; asm volatile("" : "+v"(fqq));
#pragma unroll
      for (int n = 0; n < 2; ++n) {
        const int col = fqq * 8 + n * 4;
        f32x4 al = {0.f, 0.f, 0.f, 0.f}, dtb = {0.f, 0.f, 0.f, 0.f};
        if (col >= 16) { const f32x4 t = *(const f32x4*)(a_log + col - 16); al = f32x4{__expf(t[0]), __expf(t[1]), __expf(t[2]), __expf(t[3])}; dtb = *(const f32x4*)(dt_bias + col - 16); }
#pragma unroll
        for (int ai = 0; ai < 2; ++ai)
#pragma unroll
          for (int m = 0; m < 4; ++m) {
            const int row = row0 + ai * 128 + m * 16;
            const pg8::f32x4 a = acc[ai][0][m][n];
            f32x4 o;
#pragma unroll
            for (int e = 0; e < 4; ++e) {
              if (col < 16) o[e] = sigmoidf_(a[e]);
              else { const float z = a[e] + dtb[e]; const float sp = z > 20.f ? z : log1pf(__expf(z)); o[e] = -al[e] * sp; }
            }
            *(f32x4*)(GB + (size_t)row * 32 + col) = o;
          }
      }
    }
  }
};

struct EpiG3 {
  static constexpr bool PERM = true, AFTER_DRAIN = false;
  bf16* QA; bf16* OF; const bf16* OB; const float* dn_norm; float* xch; const bf16* PO; const float* ML;
  DI void operator()(const pg8::f32x4 (&acc)[2][2][4][2], const pg8::Unit& u, int wr, int wc, int fr, int fq) const {
    const int pn = u.pn, row0 = u.pm * 256 + wr * 64 + fr, c0 = wc * 32 + fq * 8;
    if (pn < 4) {
#pragma unroll
      for (int ai = 0; ai < 2; ++ai)
#pragma unroll
        for (int m = 0; m < 4; ++m)
#pragma unroll
          for (int bj = 0; bj < 2; ++bj) {
            const int row = row0 + ai * 128 + m * 16;
            bf16* p = QA + (size_t)row * 1024 + pn * 256 + bj * 128 + c0;
            float o[8];
            if (pn == 3 && u.pm >= 32) {
              const int pc0 = (bj * 32 + ((row - SEQ) >> 8)) * 4, rr = row & 255;
              float mq[4], lq[4], mmax = -3.0e38f;
#pragma unroll
              for (int q = 0; q < 4; ++q) { const float2 t = *(const float2*)(ML + ((size_t)(pc0 + q) * 256 + rr) * 2); mq[q] = t.x; lq[q] = t.y; mmax = fmaxf(mmax, t.x); }
              float wsum = 0.f;
#pragma unroll
              for (int e = 0; e < 8; ++e) o[e] = 0.f;
#pragma unroll
              for (int q = 0; q < 4; ++q) {
                const float wq = __builtin_amdgcn_exp2f((mq[q] - mmax) * (0.088388347648318440f * 1.4426950408889634f)) * lq[q];
                float x[8]; unpack8(*(const u32x4*)(PO + ((size_t)(pc0 + q) * 256 + rr) * 128 + c0), x);
#pragma unroll
                for (int e = 0; e < 8; ++e) o[e] += wq * x[e];
                wsum += wq;
              }
              const float inv = 1.f / wsum;
#pragma unroll
              for (int e = 0; e < 8; ++e) o[e] *= inv;
            } else unpack8(*(const u32x4*)p, o);
            const pg8::f32x4 a = acc[ai][bj][m][0], b = acc[ai][bj][m][1];
            o[0] *= siluf_(a[0]); o[1] *= siluf_(a[1]); o[2] *= siluf_(a[2]); o[3] *= siluf_(a[3]);
            o[4] *= siluf_(b[0]); o[5] *= siluf_(b[1]); o[6] *= siluf_(b[2]); o[7] *= siluf_(b[3]);
            *(u32x4*)p = pack8(o);
          }
    } else {
      const f32x4 w0 = *(const f32x4*)(dn_norm + c0), w1 = *(const f32x4*)(dn_norm + c0 + 4);
#pragma unroll
      for (int ai = 0; ai < 2; ++ai)
#pragma unroll
        for (int m = 0; m < 4; ++m)
#pragma unroll
          for (int bj = 0; bj < 2; ++bj) {
            const size_t idx = (size_t)(row0 + ai * 128 + m * 16) * 1024 + (pn - 4) * 256 + bj * 128 + c0;
            float x[8], y[8]; unpack8(*(const u32x4*)(OF + idx), x); unpack8(*(const u32x4*)(OB + idx), y);
            float s = 0.f;
#pragma unroll
            for (int e = 0; e < 8; ++e) { x[e] += y[e]; s += x[e] * x[e]; }
            s += __shfl_xor(s, 16); s += __shfl_xor(s, 32);
            if (fq == 0) xch[XCH_IDX(wr, ai, m, bj, fr) + wc] = s;
          }
      asm volatile("s_waitcnt lgkmcnt(0)" ::: "memory");
      __builtin_amdgcn_s_barrier();
#pragma unroll
      for (int ai = 0; ai < 2; ++ai)
#pragma unroll
        for (int m = 0; m < 4; ++m)
#pragma unroll
          for (int bj = 0; bj < 2; ++bj) {
            const size_t idx = (size_t)(row0 + ai * 128 + m * 16) * 1024 + (pn - 4) * 256 + bj * 128 + c0;
            float x[8], y[8]; unpack8(*(const u32x4*)(OF + idx), x); unpack8(*(const u32x4*)(OB + idx), y);
            const f32x4 ps = *(const f32x4*)(xch + XCH_IDX(wr, ai, m, bj, fr));
            const float rstd = rsqrtf((ps[0] + ps[1] + ps[2] + ps[3]) * (1.f / 128.f) + EPS);
            const pg8::f32x4 a = acc[ai][bj][m][0], b = acc[ai][bj][m][1];
            float o[8];
            o[0] = (x[0] + y[0]) * rstd * w0[0] * siluf_(a[0]); o[1] = (x[1] + y[1]) * rstd * w0[1] * siluf_(a[1]);
            o[2] = (x[2] + y[2]) * rstd * w0[2] * siluf_(a[2]); o[3] = (x[3] + y[3]) * rstd * w0[3] * siluf_(a[3]);
            o[4] = (x[4] + y[4]) * rstd * w1[0] * siluf_(b[0]); o[5] = (x[5] + y[5]) * rstd * w1[1] * siluf_(b[1]);
            o[6] = (x[6] + y[6]) * rstd * w1[2] * siluf_(b[2]); o[7] = (x[7] + y[7]) * rstd * w1[3] * siluf_(b[3]);
            *(u32x4*)(OF + idx) = pack8(o);
          }
    }
  }
};

template <int MODE> struct EpiEW {
  static constexpr bool PERM = true, AFTER_DRAIN = false;
  bf16* ob; float* of; const bf16* in1;
  DI void operator()(const pg8::f32x4 (&acc)[2][2][4][2], const pg8::Unit& u, int wr, int wc, int fr, int fq) const {
    const int row0 = u.pm * 256 + wr * 64 + fr, c0 = u.pn * 256 + wc * 32 + fq * 8;
#pragma unroll
    for (int ai = 0; ai < 2; ++ai)
#pragma unroll
      for (int m = 0; m < 4; ++m)
#pragma unroll
        for (int bj = 0; bj < 2; ++bj) {
          const size_t idx = (size_t)(row0 + ai * 128 + m * 16) * 1024 + bj * 128 + c0;
          const pg8::f32x4 a = acc[ai][bj][m][0], b = acc[ai][bj][m][1];
          float v[8] = {a[0], a[1], a[2], a[3], b[0], b[1], b[2], b[3]};
          float g[8];
          if (MODE == 1 || MODE == 2 || MODE == 5 || MODE == 6) unpack8(*(const u32x4*)(in1 + idx), g);
          if (MODE == 0) {
#pragma unroll
            for (int e = 0; e < 8; ++e) v[e] = sigmoidf_(v[e]);
          } else if (MODE == 1) {
#pragma unroll
            for (int e = 0; e < 8; ++e) v[e] *= g[e];
          } else if (MODE == 2) {
            float p[8]; unpack8(*(const u32x4*)(ob + idx), p);
#pragma unroll
            for (int e = 0; e < 8; ++e) v[e] = p[e] + g[e] * v[e];
          } else if (MODE == 5 || MODE == 6) {
#pragma unroll
            for (int e = 0; e < 8; ++e) v[e] = sigmoidf_(v[e]) * g[e];
          }
          if (MODE == 3 || MODE == 5) { *(f32x4*)(of + idx) = f32x4{v[0], v[1], v[2], v[3]}; *(f32x4*)(of + idx + 4) = f32x4{v[4], v[5], v[6], v[7]}; }
          else *(u32x4*)(ob + idx) = pack8(v);
        }
  }
};

template <class Epi, bool ALIGN> DI void run_gemm(char* lds, const bf16* A, const bf16* Bt, int N, int K, const Epi& E) {
  pg8::Gemm g{A, Bt, M, N, K};
  pg8::StaticOrder S; S.init(M, N, (int)gridDim.x, (int)blockIdx.x);
  pg8::gemm_phase<Epi, pg8::StaticOrder, ALIGN, true>((PG8_LAS unsigned char*)lds, g, S, E);
}

constexpr int R_G3 = 4864, R_GA = 6912, R_GD = 7936;
DI void phase_g1(const Params& P, char* lds) {
  char* ws = P.ws;
  EpiG1 E{ws, P.q_norm, P.k_norm, P.a_log, P.dt_bias, (float*)(lds + XCH_OFF)};
  run_gemm<EpiG1, true>(lds, (const bf16*)(ws + WS_H), (const bf16*)(ws + WS_WT_IN), 4864, DM, E);
}
DI void phase_g3(const Params& P, char* lds) {
  char* ws = P.ws;
  EpiG3 E{(bf16*)(ws + WS_QA), (bf16*)P.out, (const bf16*)P.out + (size_t)M * DM, P.dn_norm, (float*)(lds + XCH_OFF), (const bf16*)(ws + WS_PB), (const float*)(ws + WS_ML)};
  run_gemm<EpiG3, true>(lds, (const bf16*)(ws + WS_H), (const bf16*)(ws + WS_WT_IN) + (size_t)R_G3 * DM, 2048, DM, E);
}
struct ChainOrder4 {
  pg8::StaticOrder so; const char* ws; const char* out;
  DI bool next(int i, pg8::Unit& u) const { if (!so.next(i >> 2, u)) return false; u.kind = i & 3; return true; }
  DI void ab(const pg8::Gemm&, const pg8::Unit& u, size_t tstep, const char*& A, const char*& B) const {
    size_t oa = WS_H; if (u.kind == 1) oa = WS_QA;
    size_t ob = WS_WT_IN + (size_t)R_GA * DM * 2; if (u.kind == 1) ob = WS_WT_BRA; if (u.kind == 2) ob = WS_WT_IN + (size_t)R_GD * DM * 2; if (u.kind == 3) ob = WS_WT_BRD;
    const char* a = ws + oa; if (u.kind == 3) a = out;
    A = a + (size_t)u.pm * tstep; B = ws + ob + (size_t)u.pn * tstep;
  }
  DI void a_ready(const pg8::Unit&) const {}
  DI void done(const pg8::Unit&) const {}
};
struct EpiG4 {
  static constexpr bool PERM = true, AFTER_DRAIN = false;
  bf16* T1; bf16* MX;
  DI void operator()(const pg8::f32x4 (&acc)[2][2][4][2], const pg8::Unit& u, int wr, int wc, int fr, int fq) const {
    const int row0 = u.pm * 256 + wr * 64 + fr, c0 = u.pn * 256 + wc * 32 + fq * 8, kind = u.kind;
#pragma unroll
    for (int ai = 0; ai < 2; ++ai)
#pragma unroll
      for (int m = 0; m < 4; ++m) {
#pragma unroll
        for (int bj = 0; bj < 2; ++bj) {
          const size_t idx = (size_t)(row0 + ai * 128 + m * 16) * 1024 + bj * 128 + c0;
          const pg8::f32x4 a = acc[ai][bj][m][0], b = acc[ai][bj][m][1];
          float v[8] = {a[0], a[1], a[2], a[3], b[0], b[1], b[2], b[3]};
          if ((kind & 1) == 0) {
#pragma unroll
            for (int e = 0; e < 8; ++e) v[e] = sigmoidf_(v[e]);
            *(u32x4*)(T1 + idx) = pack8(v);
          } else {
            float g[8]; unpack8(*(const u32x4*)(T1 + idx), g);
#pragma unroll
            for (int e = 0; e < 8; ++e) v[e] *= g[e];
            if (kind == 3) { float p[8]; unpack8(*(const u32x4*)(MX + idx), p);
#pragma unroll
              for (int e = 0; e < 8; ++e) v[e] += p[e]; }
            *(u32x4*)(MX + idx) = pack8(v);
          }
        }
        asm volatile("" ::: "memory");
      }
  }
};
DI void phase_g4(const Params& P, char* lds) {
  char* ws = P.ws;
  const bf16* WT = (const bf16*)(ws + WS_WT_IN);
  ChainOrder4 S; S.so.init(M, 1024, (int)gridDim.x, (int)blockIdx.x);
  S.ws = ws; S.out = (const char*)P.out;
  EpiG4 E{(bf16*)(ws + WS_X1B), (bf16*)(ws + WS_MIXIN)};
  pg8::Gemm g{(const bf16*)(ws + WS_H), WT + (size_t)R_GA * DM, M, 1024, DM};
  pg8::gemm_phase<EpiG4, ChainOrder4, true, true>((PG8_LAS unsigned char*)lds, g, S, E);
}
DI void phase_g5(const Params& P, char* lds) {
  char* ws = P.ws;
  EpiEW<4> E{(bf16*)(ws + WS_MIXO), nullptr, nullptr};
  run_gemm<EpiEW<4>, true>(lds, (const bf16*)(ws + WS_MIXIN), (const bf16*)(ws + WS_WT_OUT), 1024, DM, E);
}
DI void phase_g6(const Params& P, char* lds) {
  char* ws = P.ws;
  bf16* T1 = (bf16*)(ws + WS_MIXIN);
  { EpiEW<4> E{T1, nullptr, nullptr}; run_gemm<EpiEW<4>, true>(lds, (const bf16*)(ws + WS_PB), (const bf16*)(ws + WS_WT_PP), 1024, PLE, E); }
  { EpiEW<6> E{(bf16*)(ws + WS_MIXO), nullptr, T1}; run_gemm<EpiEW<6>, true>(lds, (const bf16*)(ws + WS_X1B), (const bf16*)(ws + WS_WT_PG), 1024, DM, E); }
}

DI bf16x8 ldfragP(const char* base, int stride, int row, int kbase, int hi) {
  const char* p = base + row * stride + (kbase + 4 * hi) * 2;
  const s16x4 lo = *(const s16x4*)p, h4 = *(const s16x4*)(p + 16);
  return __builtin_shufflevector(lo, h4, 0, 1, 2, 3, 4, 5, 6, 7);
}
template <int S> DI bf16x8 packacc(const f32x16& x) {
  u32x4 w = {pk2(x[8 * S], x[8 * S + 1]), pk2(x[8 * S + 2], x[8 * S + 3]), pk2(x[8 * S + 4], x[8 * S + 5]), pk2(x[8 * S + 6], x[8 * S + 7])};
  return __builtin_bit_cast(bf16x8, w);
}

DI void phase_conv(const Params& P, char* lds) {
  const int tid = threadIdx.x;
  char* ws = P.ws;
  bf16* RAW = (bf16*)(ws + WS_RAW); const bf16* HALO = (const bf16*)(ws + WS_HALO);
  float* ssp = (float*)lds;
  float* srn = (float*)(lds + 8192);
  const int cg = tid % 48, strip = tid / 48;
  const int x = cg >> 4, c8 = (cg & 15) * 8;
  for (int item = blockIdx.x; item < 2048; item += gridDim.x) {
    const int h = item & 7, chunk = item >> 3, n = chunk & 127;
    float y[8][8];
    if (tid < 384) {
      const int col = x * 1024 + h * 128 + c8;
      u32x4 xr[12];
#pragma unroll
      for (int i = 0; i < 12; ++i) {
        const int r = strip * 8 - 2 + i;
        const bf16* src;
        bool ok = true;
        if (r < 0) { ok = n > 0; src = HALO + ((size_t)(chunk - 1) * 4 + 4 + r) * 3072 + col; }
        else if (r >= 64) { ok = n < 127; src = HALO + ((size_t)(chunk + 1) * 4 + (r - 64)) * 3072 + col; }
        else src = RAW + ((size_t)chunk * 64 + r) * 3072 + col;
        xr[i] = ok ? *(const u32x4*)src : u32x4{0u, 0u, 0u, 0u};
      }
#pragma unroll
      for (int rr = 0; rr < 8; ++rr)
#pragma unroll
        for (int e = 0; e < 8; ++e) y[rr][e] = 0.f;
#pragma unroll
      for (int j = 0; j < 5; ++j) {
        const f32x4 wa = *(const f32x4*)(P.conv_w + j * 3072 + col), wb = *(const f32x4*)(P.conv_w + j * 3072 + col + 4);
#pragma unroll
        for (int rr = 0; rr < 8; ++rr) {
          const u32x4 xv = xr[rr + j];
          y[rr][0] += wa[0] * __uint_as_float(xv[0] << 16); y[rr][1] += wa[1] * __uint_as_float(xv[0] & 0xffff0000u);
          y[rr][2] += wa[2] * __uint_as_float(xv[1] << 16); y[rr][3] += wa[3] * __uint_as_float(xv[1] & 0xffff0000u);
          y[rr][4] += wb[0] * __uint_as_float(xv[2] << 16); y[rr][5] += wb[1] * __uint_as_float(xv[2] & 0xffff0000u);
          y[rr][6] += wb[2] * __uint_as_float(xv[3] << 16); y[rr][7] += wb[3] * __uint_as_float(xv[3] & 0xffff0000u);
        }
      }
#pragma unroll
      for (int rr = 0; rr < 8; ++rr) {
        float ss = 0.f;
#pragma unroll
        for (int e = 0; e < 8; ++e) { y[rr][e] = siluf_(y[rr][e]); ss += y[rr][e] * y[rr][e]; }
        if (x < 2) ssp[(x * 64 + strip * 8 + rr) * 16 + (cg & 15)] = ss;
      }
    }
    __syncthreads();
    if (tid < 128) {
      float ss = 0.f;
#pragma unroll
      for (int i = 0; i < 16; ++i) ss += ssp[tid * 16 + i];
      srn[tid] = rsqrtf(ss + EPS) * (tid < 64 ? 0.08838834764831845f : 1.f);
    }
    __syncthreads();
    if (tid < 384) {
      const int col = x * 1024 + h * 128 + c8;
#pragma unroll
      for (int rr = 0; rr < 8; ++rr) {
        const int row = strip * 8 + rr;
        const float sc = x < 2 ? srn[x * 64 + row] : 1.f;
        u32x4 o = {pk2(y[rr][0] * sc, y[rr][1] * sc), pk2(y[rr][2] * sc, y[rr][3] * sc), pk2(y[rr][4] * sc, y[rr][5] * sc), pk2(y[rr][6] * sc, y[rr][7] * sc)};
        *(u32x4*)(RAW + ((size_t)chunk * 64 + row) * 3072 + col) = o;
      }
    }
    __syncthreads();
  }
}

constexpr int D1_WAVE_LDS = 17408;
DI void phase_d1(const Params& P, char* lds) {
  const int tid = threadIdx.x, lane = tid & 63, r32 = lane & 31, hi = lane >> 5;
  const int wave = __builtin_amdgcn_readfirstlane(tid >> 6);
  char* ws = P.ws;
  const bf16* RAW = (const bf16*)(ws + WS_RAW); const float* GB = (const float*)(ws + WS_GB); bf16* TM = (bf16*)(ws + WS_TM);
  char* wl = lds + wave * D1_WAVE_LDS;
  float* sG = (float*)(wl + 16896); float* sB = sG + 64;
  for (int item = blockIdx.x * 8 + wave; item < 4096; item += gridDim.x * 8) {
    const int n = item & 127, dir = (item >> 7) & 1, h = (item >> 8) & 7, b = item >> 11;
    const int pos = n * 64 + lane, t = dir ? (SEQ - 1 - pos) : pos;
    const size_t m = (size_t)b * SEQ + t;
    const float beta = GB[m * 32 + dir * 8 + h];
    float G = GB[m * 32 + 16 + dir * 8 + h];
#pragma unroll
    for (int o = 1; o < 64; o <<= 1) { const float v = __shfl_up(G, o); if (lane >= o) G += v; }
    { const bf16* rk = RAW + m * 3072 + 1024 + h * 128;
#pragma unroll
      for (int ch = 0; ch < 16; ++ch) {
        const u32x4 xv = *(const u32x4*)(rk + ch * 8);
        *(u32x2*)(wl + lane * 264 + ch * 16) = u32x2{xv[0], xv[1]}; *(u32x2*)(wl + lane * 264 + ch * 16 + 8) = u32x2{xv[2], xv[3]};
      } }
    sG[lane] = G; sB[lane] = beta;
    ((float*)(ws + WS_GC))[(size_t)item * 64 + lane] = G;
    f32x16 c00 = {}, c10 = {}, c11 = {};
#pragma unroll
    for (int s = 0; s < 8; ++s) {
      const bf16x8 f0 = ldfragP(wl, 264, r32, s * 16, hi), f1 = ldfragP(wl, 264, 32 + r32, s * 16, hi);
      c00 = MFMA(f0, f0, c00); c10 = MFMA(f1, f0, c10); c11 = MFMA(f1, f1, c11);
    }
    float* L = (float*)wl;
    { const float Gj0 = sG[r32], Gj1 = sG[32 + r32];
      const float* sG4 = sG + 4 * hi; const float* sB4 = sB + 4 * hi; float* L4 = L + (4 * hi) * 64 + r32;
#pragma unroll
      for (int r = 0; r < 16; ++r) {
        const float bi0 = sB4[CRC(r)], bi1 = sB4[32 + CRC(r)], Gi0 = sG4[CRC(r)], Gi1 = sG4[32 + CRC(r)];
        const float l00 = (r32 < 4 * hi + CRC(r)) ? bi0 * c00[r] * __expf(Gi0 - Gj0) : 0.f;
        const float l10 = bi1 * c10[r] * __expf(Gi1 - Gj0);
        const float l11 = (r32 < 4 * hi + CRC(r)) ? bi1 * c11[r] * __expf(Gi1 - Gj1) : 0.f;
        L4[CRC(r) * 64] = l00; L4[(32 + CRC(r)) * 64] = l10; L4[(32 + CRC(r)) * 64 + 32] = l11;
      } }
    float tc[64];
#pragma unroll
    for (int i = 0; i < 64; ++i) {
      float a = (lane == i) ? 1.f : 0.f;
#pragma unroll
      for (int j4 = 0; j4 < (i + 3) / 4; ++j4) {
        const f32x4 l = *(const f32x4*)(L + i * 64 + j4 * 4);
#pragma unroll
        for (int e = 0; e < 4; ++e) if (j4 * 4 + e < i) a -= l[e] * tc[j4 * 4 + e];
      }
      tc[i] = a;
    }
    bf16* To = TM + (size_t)item * 4096;
#pragma unroll
    for (int i = 0; i < 64; ++i) To[i * 64 + lane] = f2bf(tc[i]);
  }
}

constexpr int SB_QH = 0, SB_KH = 16896, SB_VV = 33792, SB_TT = 50176, SB_G = 58880, SB_B = 59136, SB_E1 = 59392, SB_E2 = 59648, SB_SIZE = 59904, SC_AQ = 2 * SB_SIZE;
typedef __attribute__((address_space(3))) const char* lds_cptr;
typedef short v4i16_t __attribute__((ext_vector_type(4)));
DI s16x4 vtr(lds_cptr p) { return __builtin_bit_cast(s16x4, __builtin_amdgcn_ds_read_tr16_b64_v4i16((__attribute__((address_space(3))) v4i16_t*)p)); }
DI bf16x8 ldfragT(lds_cptr tp) { const s16x4 lo = vtr(tp), h4 = vtr(tp + 8 * 264); return __builtin_shufflevector(lo, h4, 0, 1, 2, 3, 4, 5, 6, 7); }

DI void delta_chain(const Params& P, char* lds, int chain) {
  int tid_ = threadIdx.x; asm volatile("" : "+v"(tid_));
  const int tid = tid_, lane = tid & 63, r32 = lane & 31, hi = lane >> 5;
  const int wave = __builtin_amdgcn_readfirstlane(tid >> 6);
  const int dir = chain & 1, h = (chain >> 1) & 7, b = chain >> 4;
  char* ws = P.ws;
  const bf16* RAW = (const bf16*)(ws + WS_RAW) + (size_t)b * SEQ * 3072 + h * 128;
  const float* GB = (const float*)(ws + WS_GB) + (size_t)b * SEQ * 32;
  const float* GC = (const float*)(ws + WS_GC) + (size_t)chain * 128 * 64;
  const bf16* TM = (const bf16*)(ws + WS_TM) + (size_t)chain * 128 * 4096;
  bf16* OD = (bf16*)P.out + (size_t)dir * M * DM + (size_t)b * SEQ * DM + h * 128;
  __syncthreads();
  if (wave >= 4) {
    const int lt = tid - 256;
    u32x4 rq[4], rk[4], rv[4], rt[2]; float rg = 0.f, rb = 0.f;
#define L_LOAD(n) do { _Pragma("unroll") for (int i = 0; i < 4; ++i) { const int id = lt + 256 * i, row = id >> 4, ck = id & 15; \
        const int pos = (n) * 64 + row, t = dir ? (SEQ - 1 - pos) : pos; const bf16* src = RAW + (size_t)t * 3072 + ck * 8; \
        rq[i] = *(const u32x4*)src; rk[i] = *(const u32x4*)(src + 1024); rv[i] = *(const u32x4*)(src + 2048); } \
      _Pragma("unroll") for (int i = 0; i < 2; ++i) rt[i] = *(const u32x4*)(TM + (size_t)(n) * 4096 + (lt + 256 * i) * 8); \
      if (lt < 64) { const int pos = (n) * 64 + lt, t = dir ? (SEQ - 1 - pos) : pos; rg = GC[(n) * 64 + lt]; rb = GB[(size_t)t * 32 + dir * 8 + h]; } } while (0)
#define L_STORE(bf) do { char* bb = lds + (bf) * SB_SIZE; _Pragma("unroll") for (int i = 0; i < 4; ++i) { const int id = lt + 256 * i, row = id >> 4, ck = id & 15; \
        *(u32x2*)(bb + SB_QH + row * 264 + ck * 16) = u32x2{rq[i][0], rq[i][1]}; *(u32x2*)(bb + SB_QH + row * 264 + ck * 16 + 8) = u32x2{rq[i][2], rq[i][3]}; \
        *(u32x2*)(bb + SB_KH + row * 264 + ck * 16) = u32x2{rk[i][0], rk[i][1]}; *(u32x2*)(bb + SB_KH + row * 264 + ck * 16 + 8) = u32x2{rk[i][2], rk[i][3]}; \
        *(u32x4*)(bb + SB_VV + row * 256 + ck * 16) = rv[i]; } \
      _Pragma("unroll") for (int i = 0; i < 2; ++i) { const int id = lt + 256 * i, row = id >> 3, ck = id & 7; \
        *(u32x2*)(bb + SB_TT + row * 136 + ck * 16) = u32x2{rt[i][0], rt[i][1]}; *(u32x2*)(bb + SB_TT + row * 136 + ck * 16 + 8) = u32x2{rt[i][2], rt[i][3]}; } \
      if (lt < 64) { ((float*)(bb + SB_G))[lt] = rg; ((float*)(bb + SB_B))[lt] = rb; ((float*)(bb + SB_E1))[lt] = __expf(rg); ((float*)(bb + SB_E2))[lt] = __expf(__shfl(rg, 63) - rg); } } while (0)
    L_LOAD(0); L_STORE(0); L_LOAD(1);
    const int bi = (wave == 4 || wave == 7) ? 0 : 1, bj = (wave == 6 || wave == 7) ? 1 : 0;
    for (int n = 0; n < 128; ++n) {
      const int cur = n & 1;
      __syncthreads();
      { const char* bb = lds + cur * SB_SIZE; const float* sG = (const float*)(bb + SB_G);
        f32x16 a = {};
        if (wave != 7) {
#pragma unroll
          for (int s = 0; s < 8; ++s) a = MFMA(ldfragP(bb + SB_QH, 264, 32 * bi + r32, s * 16, hi), ldfragP(bb + SB_KH, 264, 32 * bj + r32, s * 16, hi), a);
        }
        const int j = 32 * bj + r32; const float Gj = sG[j];
        const int ib = 32 * bi + 4 * hi;
        const float* sGi = sG + ib; char* aqb = lds + SC_AQ + ib * 136 + j * 2;
#pragma unroll
        for (int r = 0; r < 16; ++r) {
          const float v = (wave != 7 && j <= ib + CRC(r)) ? a[r] * __expf(sGi[CRC(r)] - Gj) : 0.f;
          *(bf16*)(aqb + CRC(r) * 136) = f2bf(v);
        } }
      __syncthreads();
      if (n + 1 < 128) L_STORE(cur ^ 1);
      if (n + 2 < 128) L_LOAD(n + 2);
    }
#undef L_LOAD
#undef L_STORE
  } else {
    f32x16 S0 = {}, S1 = {}, S2 = {}, S3 = {};
    const int g16 = (lane >> 4) & 1, i16 = lane & 15;
    for (int n = 0; n < 128; ++n) {
      const int cur = n & 1;
      const char* bb = lds + cur * SB_SIZE;
      const float* sB4 = (const float*)(bb + SB_B) + 4 * hi; const float* sE14 = (const float*)(bb + SB_E1) + 4 * hi; const float* sE24 = (const float*)(bb + SB_E2) + 4 * hi;
      __syncthreads();
      f32x16 o0 = {}, o1 = {};
      bf16x8 vp00, vp01, vp10, vp11, vd00, vd01, vd10, vd11;
      {
        const bf16x8 sp00 = packacc<0>(S0), sp01 = packacc<1>(S0), sp10 = packacc<0>(S1), sp11 = packacc<1>(S1);
        const bf16x8 sp20 = packacc<0>(S2), sp21 = packacc<1>(S2), sp30 = packacc<0>(S3), sp31 = packacc<1>(S3);
        f32x16 k0 = {}, k1 = {};
#define KQ_STEP(TILE, A0, A1, DB, SS, SP) do { A0 = MFMA(ldfragP(bb + TILE, 264, r32, 32 * DB + 16 * SS, hi), SP, A0); \
                                              A1 = MFMA(ldfragP(bb + TILE, 264, 32 + r32, 32 * DB + 16 * SS, hi), SP, A1); } while (0)
        KQ_STEP(SB_KH, k0, k1, 0, 0, sp00); KQ_STEP(SB_KH, k0, k1, 0, 1, sp01); KQ_STEP(SB_KH, k0, k1, 1, 0, sp10); KQ_STEP(SB_KH, k0, k1, 1, 1, sp11);
        KQ_STEP(SB_KH, k0, k1, 2, 0, sp20); KQ_STEP(SB_KH, k0, k1, 2, 1, sp21); KQ_STEP(SB_KH, k0, k1, 3, 0, sp30); KQ_STEP(SB_KH, k0, k1, 3, 1, sp31);
        { const char* vvb = bb + SB_VV + (4 * hi) * 256 + (32 * wave + r32) * 2;
#pragma unroll
          for (int r = 0; r < 16; ++r) {
            k0[r] = sB4[CRC(r)] * (bf2f(*(const bf16*)(vvb + CRC(r) * 256)) - sE14[CRC(r)] * k0[r]);
            k1[r] = sB4[32 + CRC(r)] * (bf2f(*(const bf16*)(vvb + (32 + CRC(r)) * 256)) - sE14[32 + CRC(r)] * k1[r]);
          } }
        const bf16x8 rp00 = packacc<0>(k0), rp01 = packacc<1>(k0), rp10 = packacc<0>(k1), rp11 = packacc<1>(k1);
        f32x16 v0 = {}, v1 = {};
#define T_STEP(MB, SS, RP) do { v0 = MFMA(ldfragP(bb + SB_TT, 136, r32, 32 * MB + 16 * SS, hi), RP, v0); \
                                v1 = MFMA(ldfragP(bb + SB_TT, 136, 32 + r32, 32 * MB + 16 * SS, hi), RP, v1); } while (0)
        T_STEP(0, 0, rp00); T_STEP(0, 1, rp01); T_STEP(1, 0, rp10); T_STEP(1, 1, rp11);
        vp00 = packacc<0>(v0); vp01 = packacc<1>(v0); vp10 = packacc<0>(v1); vp11 = packacc<1>(v1);
#pragma unroll
        for (int r = 0; r < 16; ++r) { v0[r] *= sE24[CRC(r)]; v1[r] *= sE24[32 + CRC(r)]; }
        vd00 = packacc<0>(v0); vd01 = packacc<1>(v0); vd10 = packacc<0>(v1); vd11 = packacc<1>(v1);
        __builtin_amdgcn_sched_barrier(0);
        KQ_STEP(SB_QH, o0, o1, 0, 0, sp00); KQ_STEP(SB_QH, o0, o1, 0, 1, sp01); KQ_STEP(SB_QH, o0, o1, 1, 0, sp10); KQ_STEP(SB_QH, o0, o1, 1, 1, sp11);
        KQ_STEP(SB_QH, o0, o1, 2, 0, sp20); KQ_STEP(SB_QH, o0, o1, 2, 1, sp21); KQ_STEP(SB_QH, o0, o1, 3, 0, sp30); KQ_STEP(SB_QH, o0, o1, 3, 1, sp31);
#pragma unroll
        for (int r = 0; r < 16; ++r) { o0[r] *= sE14[CRC(r)]; o1[r] *= sE14[32 + CRC(r)]; }
      }
      __syncthreads();
#define A_STEP(MB, SS, VP) do { o0 = MFMA(ldfragP(lds + SC_AQ, 136, r32, 32 * MB + 16 * SS, hi), VP, o0); \
                                o1 = MFMA(ldfragP(lds + SC_AQ, 136, 32 + r32, 32 * MB + 16 * SS, hi), VP, o1); } while (0)
      A_STEP(0, 0, vp00); A_STEP(0, 1, vp01); A_STEP(1, 0, vp10); A_STEP(1, 1, vp11);
      { const int pb = n * 64 + 4 * hi, tb = dir ? (SEQ - 1 - pb) : pb;
        bf16* odb = OD + (size_t)tb * DM + 32 * wave + r32;
        const long sgn = dir ? -(long)DM : (long)DM;
#pragma unroll
        for (int r = 0; r < 16; ++r) { odb[sgn * CRC(r)] = (bf16)pk2(o0[r], 0.f); odb[sgn * (32 + CRC(r))] = (bf16)pk2(o1[r], 0.f); } }
      const float eg = ((const float*)(bb + SB_E1))[63];
#pragma unroll
      for (int r = 0; r < 16; ++r) { S0[r] *= eg; S1[r] *= eg; S2[r] *= eg; S3[r] *= eg; }
      { const lds_cptr kt = (lds_cptr)(bb + SB_KH) + (4 * hi + (i16 >> 2)) * 264 + (16 * g16 + 4 * (i16 & 3)) * 2;
#define S_STEP(SX, DB) do { SX = MFMA(ldfragT(kt + (DB) * 64), vd00, SX); SX = MFMA(ldfragT(kt + (DB) * 64 + 16 * 264), vd01, SX); \
                            SX = MFMA(ldfragT(kt + (DB) * 64 + 32 * 264), vd10, SX); SX = MFMA(ldfragT(kt + (DB) * 64 + 48 * 264), vd11, SX); } while (0)
        S_STEP(S0, 0); S_STEP(S1, 1); S_STEP(S2, 2); S_STEP(S3, 3); }
    }
#undef KQ_STEP
#undef T_STEP
#undef A_STEP
#undef S_STEP
  }
  __syncthreads();
}

namespace att {
constexpr int D = 128, NW = 8, QBLK = 32, KVBLK = 64;
constexpr float SCALE = 0.088388347648318440f;
constexpr float THR = 8.f;
constexpr int LDQ = 1024, LDK = 256, LDO = 1024;
constexpr size_t SHM_V = KVBLK * D * 2, SHM_K = KVBLK * D * 2, SHM_ATTN = 2 * SHM_V + 2 * SHM_K + NW * 64 * 4;
using f32x8 = __attribute__((ext_vector_type(8))) float;
#define KSWZ(row, colB) ((row) * 256 + ((colB) ^ (((row) & 7) << 4)))
#define SBAR() __builtin_amdgcn_sched_barrier(0)
DI unsigned cvtpk(float lo, float hi) { unsigned r; asm volatile("v_cvt_pk_bf16_f32 %0, %1, %2" : "=v"(r) : "v"(lo), "v"(hi)); return r; }
DI bf16x8 ld8(const bf16* p) { return *reinterpret_cast<const bf16x8*>(p); }

DI void partialSM(f32x16& p0, f32x16& p1, float mnC) {
  constexpr float C = SCALE * 1.4426950408889634f;
  asm volatile("" : "+v"(p0), "+v"(p1));
  for (int r = 0; r < 16; ++r) p0[r] = fmaf(p0[r], C, mnC); for (int r = 0; r < 16; ++r) p1[r] = fmaf(p1[r], C, mnC);
  for (int r = 0; r < 16; ++r) p0[r] = __builtin_amdgcn_exp2f(p0[r]);
}
DI void finishSM(f32x16& p0, f32x16& p1, float& l_reg, bf16x8& pa0, bf16x8& pa1, bf16x8& pa2, bf16x8& pa3) {
  for (int r = 0; r < 16; ++r) p1[r] = __builtin_amdgcn_exp2f(p1[r]);
  float ps = 0; for (int r = 0; r < 16; ++r) ps += p0[r]; for (int r = 0; r < 16; ++r) ps += p1[r];
  l_reg += ps;
#define PK4(P, BASE, OUT) do { unsigned a0 = cvtpk(P[BASE + 0], P[BASE + 1]), a1 = cvtpk(P[BASE + 2], P[BASE + 3]);   \
    unsigned b0 = cvtpk(P[BASE + 4], P[BASE + 5]), b1 = cvtpk(P[BASE + 6], P[BASE + 7]);                              \
    auto r0 = __builtin_amdgcn_permlane32_swap(a0, b0, false, false); auto r1 = __builtin_amdgcn_permlane32_swap(a1, b1, false, false); \
    u32x4 w = {r0[0], r1[0], r0[1], r1[1]}; OUT = *reinterpret_cast<bf16x8*>(&w); } while (0)
  PK4(p0, 0, pa0); PK4(p0, 8, pa1); PK4(p1, 0, pa2); PK4(p1, 8, pa3);
#undef PK4
}
DI void qkt(f32x16& p0, f32x16& p1, const bf16* Ks, const bf16x8* qr, int r32, int hi) {
  p0 = f32x16{}; p1 = f32x16{};
  for (int d0 = 0; d0 < 8; ++d0) { int cb = (d0 * 16 + hi * 8) * 2;
    bf16x8 b0 = *reinterpret_cast<const bf16x8*>((const char*)Ks + KSWZ(r32, cb));
    bf16x8 b1 = *reinterpret_cast<const bf16x8*>((const char*)Ks + KSWZ(32 + r32, cb));
    p0 = __builtin_amdgcn_mfma_f32_32x32x16_bf16(b0, qr[d0], p0, 0, 0, 0);
    p1 = __builtin_amdgcn_mfma_f32_32x32x16_bf16(b1, qr[d0], p1, 0, 0, 0); }
}
DI int v_st(int k, int c) { const int kk = (k & ~0xC) | ((k & 4) << 1) | ((k & 8) >> 1); return ((kk >> 3) * 4 + (c >> 5)) * 512 + ((kk & 7) * 32 + (c & 31)) * 2; }
DI int v_rd_base(int lane) { return ((lane & 3) << 3) | (((lane >> 2) & 3) << 6) | (((lane >> 4) & 1) << 5) | (((lane >> 5) & 1) << 8); }
constexpr int v_rd_off(int d0, int ks, int half) { return d0 * 512 + ks * 4096 + half * 2048; }
template <int OFF> DI s16x4 tr_read(int vb) {
  s16x4 r; asm volatile("ds_read_b64_tr_b16 %0, %1 offset:%2" : "=&v"(r) : "v"(vb), "i"(OFF) : "memory"); return r;
}
template <int D0> DI void pv_one(f32x16& od, int vb, bf16x8 pa0, bf16x8 pa1, bf16x8 pa2, bf16x8 pa3) {
  const s16x4 l0 = tr_read<v_rd_off(D0, 0, 0)>(vb), h0 = tr_read<v_rd_off(D0, 0, 1)>(vb), l1 = tr_read<v_rd_off(D0, 1, 0)>(vb), h1 = tr_read<v_rd_off(D0, 1, 1)>(vb);
  const s16x4 l2 = tr_read<v_rd_off(D0, 2, 0)>(vb), h2 = tr_read<v_rd_off(D0, 2, 1)>(vb), l3 = tr_read<v_rd_off(D0, 3, 0)>(vb), h3 = tr_read<v_rd_off(D0, 3, 1)>(vb);
  asm volatile("s_waitcnt lgkmcnt(0)" ::: "memory"); SBAR();
#define PK(L, H) (bf16x8){L[0], L[1], L[2], L[3], H[0], H[1], H[2], H[3]}
  od = __builtin_amdgcn_mfma_f32_32x32x16_bf16(pa0, PK(l0, h0), od, 0, 0, 0);
  od = __builtin_amdgcn_mfma_f32_32x32x16_bf16(pa1, PK(l1, h1), od, 0, 0, 0);
  od = __builtin_amdgcn_mfma_f32_32x32x16_bf16(pa2, PK(l2, h2), od, 0, 0, 0);
  od = __builtin_amdgcn_mfma_f32_32x32x16_bf16(pa3, PK(l3, h3), od, 0, 0, 0);
#undef PK
}
DI void pv_d0(f32x16* o, int vb, bf16x8 pa0, bf16x8 pa1, bf16x8 pa2, bf16x8 pa3) {
  pv_one<0>(o[0], vb, pa0, pa1, pa2, pa3); pv_one<1>(o[1], vb, pa0, pa1, pa2, pa3); pv_one<2>(o[2], vb, pa0, pa1, pa2, pa3); pv_one<3>(o[3], vb, pa0, pa1, pa2, pa3);
}

DI void attn_dense_body(const bf16* Qb, const bf16* __restrict__ Kh, const bf16* __restrict__ Vh, bf16* Ob, int ldo, float* ml, int seq, char* lds, float mnC) {
  constexpr int SDEPTH = 1;
  const int tid = threadIdx.x, wid = tid >> 6, lane = tid & 63, r32 = lane & 31, hi = lane >> 5;
  bf16* V_lds = (bf16*)lds; bf16* K_lds = (bf16*)(lds + 2 * SHM_V);
  float* ws = (float*)(lds + 2 * SHM_V + 2 * SHM_K) + wid * 64; float* li_l = ws; float* al_l = ws + 32;
  float l_reg = 0; f32x16 o[4] = {}; bf16x8 qr[8];
  const bf16* Qw = Qb + (long)(wid * QBLK + r32) * LDQ + hi * 8;
#pragma unroll
  for (int d0 = 0; d0 < 8; ++d0) qr[d0] = ld8(Qw + d0 * 16);
  const int sr = tid >> 4, sc = (tid & 15) * 8, vst0 = v_st(sr, sc), vst1 = v_st(32 + sr, sc);
  const int vb0 = (int)(uintptr_t)V_lds + v_rd_base(lane);
  struct { bf16x8 ks0, ks1; } sr_[SDEPTH];
#define SLOAD(i, k0) do { sr_[i].vs0 = ld8(&Vh[(long)((k0) + sr) * LDK + sc]); sr_[i].vs1 = ld8(&Vh[(long)((k0) + 32 + sr) * LDK + sc]); \
    sr_[i].ks0 = ld8(&Kh[(long)((k0) + sr) * LDK + sc]); sr_[i].ks1 = ld8(&Kh[(long)((k0) + 32 + sr) * LDK + sc]); } while (0)
#define SWRITE(b, i) do { *(bf16x8*)((char*)V_lds + (b) * SHM_V + vst0) = sr_[i].vs0;          \
    *(bf16x8*)((char*)V_lds + (b) * SHM_V + vst1) = sr_[i].vs1; int kc = sc * 2;               \
    *(bf16x8*)((char*)K_lds + (b) * SHM_K + KSWZ(sr, kc)) = sr_[i].ks0;                       \
    *(bf16x8*)((char*)K_lds + (b) * SHM_K + KSWZ(32 + sr, kc)) = sr_[i].ks1; } while (0)
#define SWAIT() do { asm volatile("s_waitcnt vmcnt(0)" ::: "memory"); } while (0)
  f32x16 pA0, pA1, pB0, pB1; bf16x8 pa0, pa1, pa2, pa3; const int NT = seq / KVBLK;
#define LOADK(k0) do { sr_[0].ks0 = ld8(&Kh[(long)((k0) + sr) * LDK + sc]); sr_[0].ks1 = ld8(&Kh[(long)((k0) + 32 + sr) * LDK + sc]); } while (0)
#define LOADV(k0) do { sr_[0].ks0 = ld8(&Vh[(long)((k0) + sr) * LDK + sc]); sr_[0].ks1 = ld8(&Vh[(long)((k0) + 32 + sr) * LDK + sc]); } while (0)
#define WRITEK(b) do { const int kc = sc * 2; *(bf16x8*)((char*)K_lds + (b) * SHM_K + KSWZ(sr, kc)) = sr_[0].ks0; *(bf16x8*)((char*)K_lds + (b) * SHM_K + KSWZ(32 + sr, kc)) = sr_[0].ks1; } while (0)
#define WRITEV(b) do { *(bf16x8*)((char*)V_lds + (b) * SHM_V + vst0) = sr_[0].ks0; *(bf16x8*)((char*)V_lds + (b) * SHM_V + vst1) = sr_[0].ks1; } while (0)
  {
    const bf16x8 a0 = ld8(&Kh[(long)sr * LDK + sc]), a1 = ld8(&Kh[(long)(32 + sr) * LDK + sc]);
    const bf16x8 b0 = ld8(&Vh[(long)sr * LDK + sc]), b1 = ld8(&Vh[(long)(32 + sr) * LDK + sc]);
    const bf16x8 c0 = ld8(&Kh[(long)(KVBLK + sr) * LDK + sc]), c1 = ld8(&Kh[(long)(KVBLK + 32 + sr) * LDK + sc]);
    LOADV(KVBLK);
    const int kc = sc * 2;
    *(bf16x8*)((char*)K_lds + KSWZ(sr, kc)) = a0; *(bf16x8*)((char*)K_lds + KSWZ(32 + sr, kc)) = a1;
    *(bf16x8*)((char*)V_lds + vst0) = b0; *(bf16x8*)((char*)V_lds + vst1) = b1;
    *(bf16x8*)((char*)K_lds + SHM_K + KSWZ(sr, kc)) = c0; *(bf16x8*)((char*)K_lds + SHM_K + KSWZ(32 + sr, kc)) = c1;
    __syncthreads(); }
  qkt(pA0, pA1, K_lds, qr, r32, hi); partialSM(pA0, pA1, mnC);
  for (int j = 1; j + 1 < NT; j += 2) {
    SBAR(); qkt(pB0, pB1, (bf16*)((char*)K_lds + SHM_K), qr, r32, hi);
    SWAIT(); WRITEV(1); LOADK((j + 1) * KVBLK);
    finishSM(pA0, pA1, l_reg, pa0, pa1, pa2, pa3); SBAR();
    pv_d0(o, vb0, pa0, pa1, pa2, pa3); partialSM(pB0, pB1, mnC);
    SWAIT(); WRITEK(0); LOADV((j + 1) * KVBLK); __syncthreads();
    SBAR(); qkt(pA0, pA1, K_lds, qr, r32, hi);
    SWAIT(); WRITEV(0); LOADK((j + 2) * KVBLK);
    finishSM(pB0, pB1, l_reg, pa0, pa1, pa2, pa3); SBAR();
    pv_d0(o, vb0 + (int)SHM_V, pa0, pa1, pa2, pa3); partialSM(pA0, pA1, mnC);
    SWAIT(); WRITEK(1); LOADV((j + 2) * KVBLK); __syncthreads();
  }
  SBAR(); qkt(pB0, pB1, (bf16*)((char*)K_lds + SHM_K), qr, r32, hi);
  finishSM(pA0, pA1, l_reg, pa0, pa1, pa2, pa3); SBAR();
  pv_d0(o, vb0, pa0, pa1, pa2, pa3); partialSM(pB0, pB1, mnC);
  SWAIT(); WRITEV(1); __syncthreads();
  finishSM(pB0, pB1, l_reg, pa0, pa1, pa2, pa3); SBAR();
  pv_d0(o, vb0 + (int)SHM_V, pa0, pa1, pa2, pa3);
#undef LOADK
#undef LOADV
#undef WRITEK
#undef WRITEV
  { auto rr = __builtin_amdgcn_permlane32_swap(__float_as_uint(l_reg), __float_as_uint(l_reg), false, false); l_reg = __uint_as_float(rr[0]) + __uint_as_float(rr[1]); }
  if (hi == 0) { li_l[r32] = l_reg; if (ml) { ml[(wid * QBLK + r32) * 2] = 0.f; ml[(wid * QBLK + r32) * 2 + 1] = l_reg; } }
  asm volatile("s_waitcnt lgkmcnt(0)" ::: "memory");
  float rli[16];
#pragma unroll
  for (int r = 0; r < 16; ++r) rli[r] = __builtin_amdgcn_rcpf(li_l[crow(r, hi)]);
  bf16* Ow = Ob + (long)(wid * QBLK) * ldo;
#pragma unroll
  for (int r = 0; r < 16; ++r) { int orow = crow(r, hi);
    for (int d0 = 0; d0 < 4; ++d0) Ow[(long)orow * ldo + d0 * 32 + r32] = f2bf(o[d0][r] * rli[r]); }
#undef SLOAD
#undef SWRITE
#undef SWAIT
#undef RESC
}
}

DI void phase_mix(const Params& P, char* lds) {
  char* ws = P.ws;
#ifndef NO_DELTA
  for (int chain = blockIdx.x; chain < 32; chain += gridDim.x) delta_chain(P, lds, chain);
#endif
  unsigned* counter = (unsigned*)(ws + WS_MISC + 65536);
  volatile int* su = (volatile int*)(lds + LDS_BYTES - 16);
  bf16* QA = (bf16*)(ws + WS_QA); const bf16* KA = (const bf16*)(ws + WS_KA); const bf16* VA = (const bf16*)(ws + WS_VA);
  float gq, gk;
  { const int ln = threadIdx.x & 63;
    gq = fmaxf(fabsf(P.q_norm[ln]), fabsf(P.q_norm[ln + 64])); gk = fmaxf(fabsf(P.k_norm[ln]), fabsf(P.k_norm[ln + 64]));
    for (int o = 32; o > 0; o >>= 1) { gq = fmaxf(gq, __shfl_xor(gq, o)); gk = fmaxf(gk, __shfl_xor(gk, o)); } }
  const float mnC = -(gq * gk * 11.313708499f * 1.02f + 0.1f) * 1.4426950408889634f;
  if (threadIdx.x == 0) *su = (int)atomicAdd(counter, 1u);
  __syncthreads();
  for (;;) {
    const int it = *su;
    if (it >= 704) break;
    int nxt = -1;
    if (threadIdx.x == 0 && it < 448) nxt = (int)atomicAdd(counter, 1u);
    const int u = it < 448 ? it : 448 + ((it - 448) >> 2), qtr = (it - 448) & 3;
    const int qb = u & 31, hq = (u >> 5) & 7, b = u >> 8, kvh = hq >> 2;
    bf16* q0 = QA + ((size_t)b * SEQ + qb * 256) * 1024 + hq * 128;
    const bf16* k0 = KA + (size_t)b * SEQ * 256 + kvh * 128;
    const bf16* v0 = VA + (size_t)b * SEQ * 256 + kvh * 128;
    if (it < 448) att::attn_dense_body(q0, k0, v0, q0, 1024, nullptr, SEQ, lds, mnC);
    else {
      const int pc = it - 448;
      att::attn_dense_body(q0, k0 + (size_t)qtr * 2048 * 256, v0 + (size_t)qtr * 2048 * 256, (bf16*)(ws + WS_PB) + (size_t)pc * 256 * 128, 128, (float*)(ws + WS_ML) + (size_t)pc * 512, 2048, lds, mnC);
    }
    __syncthreads();
    if (threadIdx.x == 0) *su = nxt >= 0 ? nxt : (int)atomicAdd(counter, 1u);
    __syncthreads();
  }
}

DI void phase_rownorm(const float* __restrict__ base, const bf16* __restrict__ src, const float* __restrict__ w, float* dst, bf16* dstb) {
  const int tid = threadIdx.x, wave = tid >> 6, lane = tid & 63;
  for (int row = blockIdx.x * 8 + wave; row < M; row += gridDim.x * 8) {
    const size_t ro = (size_t)row * DM;
    f32x4 v[4]; float ss = 0.f;
#pragma unroll
    for (int i = 0; i < 4; ++i) { const u32x2 sv = *(const u32x2*)(src + ro + i * 256 + lane * 4);
      v[i] = f32x4{__uint_as_float(sv[0] << 16), __uint_as_float(sv[0] & 0xffff0000u), __uint_as_float(sv[1] << 16), __uint_as_float(sv[1] & 0xffff0000u)};
      ss += v[i][0] * v[i][0] + v[i][1] * v[i][1] + v[i][2] * v[i][2] + v[i][3] * v[i][3]; }
    ss = wave_sum(ss);
    const float rstd = rsqrtf(ss * (1.f / DM) + EPS);
#pragma unroll
    for (int i = 0; i < 4; ++i) {
      const f32x4 ww = *(const f32x4*)(w + i * 256 + lane * 4);
      const f32x4 bb = *(const f32x4*)(base + ro + i * 256 + lane * 4);
      f32x4 o;
#pragma unroll
      for (int e = 0; e < 4; ++e) o[e] = bb[e] + v[i][e] * rstd * ww[e];
      *(f32x4*)(dst + ro + i * 256 + lane * 4) = o;
      if (dstb) { u32x2 ob = {pk2(o[0], o[1]), pk2(o[2], o[3])}; *(u32x2*)(dstb + ro + i * 256 + lane * 4) = ob; }
    }
  }
}

#define LAS __attribute__((address_space(3)))
#define XB_TMO      128
#define XB_XCNT(j)  (256  + 64 * (j))
#define XB_XSUB(j)  (1280 + 64 * (j))
#define XB_XGEN(j)  (2304 + 64 * (j))
#define XB_TOP      3328
#define XB_TOPGEN   3392
#define XCD_BAR_WORDS 3456
#define XB_SPIN_CAP (1u << 18)

__device__ __forceinline__ unsigned xb_ld(unsigned* p)              { return __hip_atomic_load(p, __ATOMIC_RELAXED, __HIP_MEMORY_SCOPE_AGENT); }
__device__ __forceinline__ unsigned xb_add(unsigned* p, unsigned v) { return __hip_atomic_fetch_add(p, v, __ATOMIC_RELAXED, __HIP_MEMORY_SCOPE_AGENT); }
__device__ __forceinline__ unsigned xb_xcc_id() { return (unsigned)__builtin_amdgcn_s_getreg((3 << 11) | 20) & 0xFu; }
#define XB_SPIN(cond, bar) do { unsigned _sp = 0; while (cond) { __builtin_amdgcn_s_sleep(1); \
    if ((++_sp & 255u) == 0u) { if (xb_ld(&(bar)[XB_TMO])) break; if (_sp > XB_SPIN_CAP) { atomicAdd(&(bar)[XB_TMO], 1u); break; } } } } while (0)

struct XcdBarrier {
    unsigned* bar; unsigned x;
    volatile LAS unsigned* st;
};

__device__ __forceinline__ XcdBarrier xcd_barrier_post(unsigned* bar, volatile LAS unsigned* st) {
    XcdBarrier b; b.bar = bar; b.x = xb_xcc_id(); b.st = st;
    if (threadIdx.x == 0) (void)xb_add(&bar[XB_XCNT(b.x)], 1u);
    return b;
}
__device__ __forceinline__ void xcd_barrier_complete(unsigned* bar, unsigned x, unsigned& nloc, unsigned& nx) {
    const unsigned G = gridDim.x * gridDim.y * gridDim.z;
    unsigned sum, cnt, mine, sp = 0u;
    for (;;) {
        sum = 0u; cnt = 0u; mine = 0u;
#pragma unroll
        for (unsigned j = 0; j < 16; ++j) { const unsigned c = xb_ld(&bar[XB_XCNT(j)]); sum += c; cnt += (c > 0u) ? 1u : 0u; mine = (j == x) ? c : mine; }
        if (sum == G) break;
        __builtin_amdgcn_s_sleep(1);
        if ((++sp & 255u) == 0u) { if (xb_ld(&bar[XB_TMO])) break; if (sp > XB_SPIN_CAP) { atomicAdd(&bar[XB_TMO], 1u); break; } }
    }
    nloc = mine > 0u ? mine : 1u; nx = cnt > 0u ? cnt : 1u;
}

__device__ __forceinline__ void xcd_barrier(const XcdBarrier& b) {
    asm volatile("s_waitcnt vmcnt(0)" ::: "memory");
    __syncthreads();
    if (threadIdx.x == 0) {
        unsigned* bar = b.bar;
        __builtin_amdgcn_s_waitcnt(0);
        unsigned nloc = b.st[0], nx = b.st[1];
        if (nloc == 0u) { xcd_barrier_complete(bar, b.x, nloc, nx); b.st[0] = nloc; b.st[1] = nx; }
        const unsigned old = xb_add(&bar[XB_XSUB(b.x)], 1u);
        const unsigned gen = old / nloc;
        if (old + 1u == (gen + 1u) * nloc) {
            __builtin_amdgcn_fence(__ATOMIC_RELEASE, "agent");
            asm volatile("s_waitcnt vmcnt(0)" ::: "memory");
            const unsigned og = xb_add(&bar[XB_TOP], 1u);
            const unsigned tg = og / nx;
            if (og + 1u == (tg + 1u) * nx) xb_add(&bar[XB_TOPGEN], 1u);
            else XB_SPIN(xb_ld(&bar[XB_TOPGEN]) == tg, bar);
            __builtin_amdgcn_fence(__ATOMIC_ACQUIRE, "agent");
            xb_add(&bar[XB_XGEN(b.x)], 1u);
            asm volatile("s_waitcnt vmcnt(0)" ::: "memory");
        } else {
            XB_SPIN(xb_ld(&bar[XB_XGEN(b.x)]) == gen, bar);
            __builtin_amdgcn_fence(__ATOMIC_ACQUIRE, "agent");
            asm volatile("s_waitcnt vmcnt(0)" ::: "memory");
        }
    }
    __syncthreads();
}

__global__ void __launch_bounds__(512) mega(Params P) {
  extern __shared__ __attribute__((aligned(16))) char lds[];
  cg::grid_group grid = cg::this_grid();
#ifndef PHMASK
#define PHMASK 0x7ff
#endif
#define PH(k) ((((PHMASK) >> (k)) & 1) && P.ph_lo <= (k) && (k) < P.ph_hi)
  volatile LAS unsigned* bst = (volatile LAS unsigned*)(lds + LDS_BYTES - 32);
  if (threadIdx.x == 0) { bst[0] = 0u; bst[1] = 0u; }
  __syncthreads();
  const XcdBarrier bar = xcd_barrier_post((unsigned*)(P.ws + WS_BAR), bst);
#define SYNC(k) do { if (PH(k) && PH((k) + 1)) xcd_barrier(bar); } while (0)
  if (P.ph_hi > 1000) grid.sync();
  char* ws = P.ws;
  if (PH(0)) phase0(P, lds);
  SYNC(0);
  if (PH(1)) phase_g1(P, lds);
  SYNC(1);
  if (PH(2)) phase_conv(P, lds);
  SYNC(2);
  if (PH(3)) phase_d1(P, lds);
  SYNC(3);
  if (PH(4)) phase_mix(P, lds);
  SYNC(4);
  if (PH(5)) phase_g3(P, lds);
  SYNC(5);
  if (PH(6)) phase_g4(P, lds);
  SYNC(6);
  if (PH(7)) phase_g5(P, lds);
  SYNC(7);
  if (PH(8)) { phase_rownorm(P.x, (const bf16*)(ws + WS_MIXO), P.norm_post, P.out, (bf16*)(ws + WS_X1B)); phase_pconv(P); }
  SYNC(8);
  if (PH(9)) phase_g6(P, lds);
  SYNC(9);
  if (PH(10)) phase_rownorm(P.out, (const bf16*)(ws + WS_MIXO), P.ple_norm, P.out, nullptr);
}

extern "C" void kernel_launch(void* const* d_in, const int* in_sizes, int n_in, void* d_out, int out_size, void* d_ws, size_t ws_size, hipStream_t stream) {
  static int grid_blocks = 0;
  if (grid_blocks == 0) {
    if (n_in != 17 || out_size != M * DM || ws_size < WS_END) { fprintf(stderr, "kernel_launch: unexpected shapes (n_in %d out %d ws %zu)\n", n_in, out_size, ws_size); grid_blocks = -1; return; }
    int dev = 0, cus = 0, per_cu = 0;
    hipGetDevice(&dev);
    hipDeviceGetAttribute(&cus, hipDeviceAttributeMultiprocessorCount, dev);
    if (hipFuncSetAttribute((const void*)mega, hipFuncAttributeMaxDynamicSharedMemorySize, LDS_BYTES) != hipSuccess) { fprintf(stderr, "kernel_launch: hipFuncSetAttribute failed\n"); grid_blocks = -1; return; }
    if (hipOccupancyMaxActiveBlocksPerMultiprocessor(&per_cu, (const void*)mega, 512, LDS_BYTES) != hipSuccess || per_cu < 1) { fprintf(stderr, "kernel_launch: occupancy query gave %d\n", per_cu); per_cu = 1; }
    (void)hipGetLastError();
    grid_blocks = cus * per_cu;
  }
  if (grid_blocks < 0) return;
  Params p{};
  p.x = (const float*)d_in[0]; p.p = (const float*)d_in[1]; p.norm_pre = (const float*)d_in[2]; p.w_in = (const float*)d_in[3];
  p.q_norm = (const float*)d_in[4]; p.k_norm = (const float*)d_in[5]; p.conv_w = (const float*)d_in[6]; p.a_log = (const float*)d_in[7];
  p.dt_bias = (const float*)d_in[8]; p.dn_norm = (const float*)d_in[9]; p.w_br_att = (const float*)d_in[10]; p.w_br_dn = (const float*)d_in[11];
  p.w_out = (const float*)d_in[12]; p.norm_post = (const float*)d_in[13]; p.w_ple_proj = (const float*)d_in[14]; p.w_ple_gate = (const float*)d_in[15];
  p.ple_norm = (const float*)d_in[16];
  p.out = (float*)d_out; p.ws = (char*)d_ws; p.ph_lo = 0; p.ph_hi = 11;
  if (hipMemsetAsync((char*)d_ws + WS_MISC + 65536, 0, 65536 + 16384, stream) != hipSuccess) { fprintf(stderr, "kernel_launch: memset failed\n"); return; }
  void* args[] = {&p};
  hipError_t e = hipLaunchCooperativeKernel((const void*)mega, dim3(grid_blocks), dim3(512), args, LDS_BYTES, stream);
  if (e != hipSuccess) fprintf(stderr, "kernel_launch: cooperative launch failed: %s (grid %d)\n", hipGetErrorString(e), grid_blocks);
}
```

```cpp
#include <hip/hip_runtime.h>
#include <hip/hip_cooperative_groups.h>
#include <cstdio>
#include <cstdint>
namespace cg = cooperative_groups;

using bf16 = unsigned short;
using bf16x8 = __attribute__((ext_vector_type(8))) short;
using s16x4  = __attribute__((ext_vector_type(4))) short;
using f32x16 = __attribute__((ext_vector_type(16))) float;
using f32x4  = __attribute__((ext_vector_type(4))) float;
using u32x4  = __attribute__((ext_vector_type(4))) unsigned;
using u32x2  = __attribute__((ext_vector_type(2))) unsigned;
typedef __bf16 bf16x2_t __attribute__((ext_vector_type(2)));
typedef float f32x2_t __attribute__((ext_vector_type(2)));
#define DI __device__ __forceinline__
#define MFMA(a, b, c) __builtin_amdgcn_mfma_f32_32x32x16_bf16((a), (b), (c), 0, 0, 0)

constexpr int M = 16384, SEQ = 8192, DM = 1024, INW = 8736, PLE = 256;
constexpr int C_AQ = 0, C_AK = 1024, C_AV = 1280, C_AZ = 1536, C_DQ = 2560, C_DB = 5632, C_DZ = 5664, C_GA = 6688, C_GD = 7712;
constexpr float EPS = 1e-6f;
constexpr size_t MiB = 1u << 20;
constexpr size_t WS_WT_IN = 0, WS_WT_BRA = 18 * MiB, WS_WT_BRD = 20 * MiB, WS_WT_OUT = 22 * MiB, WS_WT_PG = 24 * MiB, WS_WT_PP = 26 * MiB;
constexpr size_t WS_BAR = 29 * MiB + 131072;
constexpr size_t WS_ML = 31 * MiB;
constexpr size_t WS_HALO = 248 * MiB;
constexpr size_t WS_GB = 27 * MiB, WS_MISC = 29 * MiB, WS_GC = 30 * MiB;
constexpr size_t WS_H = 32 * MiB, WS_QA = 64 * MiB, WS_KA = 96 * MiB, WS_VA = 104 * MiB, WS_RAW = 112 * MiB, WS_TM = 208 * MiB, WS_PB = 240 * MiB;
constexpr size_t WS_MIXIN = 112 * MiB, WS_MIXO = 144 * MiB, WS_X1B = 208 * MiB, WS_END = 256 * MiB;
constexpr int LDS_BYTES = 141312 + 64;

struct Params {
  const float *x, *p, *norm_pre, *w_in, *q_norm, *k_norm, *conv_w, *a_log, *dt_bias, *dn_norm, *w_br_att, *w_br_dn, *w_out, *norm_post, *w_ple_proj, *w_ple_gate, *ple_norm;
  float* out; char* ws; int ph_lo, ph_hi;
};

DI float bf2f(unsigned short v) { return __uint_as_float(((unsigned)v) << 16); }
DI unsigned short f2bf(float f) { unsigned u = __float_as_uint(f); u += 0x7fffu + ((u >> 16) & 1u); return (unsigned short)(u >> 16); }
DI unsigned pk2(float lo, float hi) { f32x2_t v = {lo, hi}; bf16x2_t b = __builtin_convertvector(v, bf16x2_t); return __builtin_bit_cast(unsigned, b); }
DI int crow(int r, int hi) { return (r & 3) + 8 * (r >> 2) + 4 * hi; }
#define CRC(r) (((r) & 3) + 8 * ((r) >> 2))
DI float wave_sum(float v) { for (int o = 32; o > 0; o >>= 1) v += __shfl_xor(v, o); return v; }
DI float half_sum(float v) { for (int o = 16; o > 0; o >>= 1) v += __shfl_xor(v, o); return v; }
DI float sigmoidf_(float x) { return __builtin_amdgcn_rcpf(1.f + __expf(-x)); }
DI float siluf_(float x) { return x * __builtin_amdgcn_rcpf(1.f + __expf(-x)); }

DI int remap_in(int n) {
  if (n < 1536) return n; if (n < 2560) return n - 1536 + 4864; if (n < 5664) return n - 2560 + 1536; if (n < 6688) return n - 5664 + 5888; return n - 6688 + 6912;
}
template <bool REMAP> DI void transpose_w(const float* __restrict__ W, int K, int N, bf16* __restrict__ WT, float* sl) {
  const int tid = threadIdx.x;
  const int ktiles = K / 64, ntiles = (N + 63) / 64;
  for (int tile = blockIdx.x; tile < ktiles * ntiles; tile += gridDim.x) {
    const int kt = tile % ktiles, nt = tile / ktiles;
#pragma unroll
    for (int i = 0; i < 8; ++i) {
      const int kl = (tid >> 6) + i * 8, nl = tid & 63, n = nt * 64 + nl;
      sl[kl * 65 + nl] = (n < N) ? __builtin_nontemporal_load(W + (size_t)(kt * 64 + kl) * N + n) : 0.f;
    }
    __syncthreads();
    const int nl = tid >> 3, kc = (tid & 7) * 8, n = nt * 64 + nl;
    if (n < N) {
      u32x4 w;
      w[0] = pk2(sl[(kc + 0) * 65 + nl], sl[(kc + 1) * 65 + nl]); w[1] = pk2(sl[(kc + 2) * 65 + nl], sl[(kc + 3) * 65 + nl]);
      w[2] = pk2(sl[(kc + 4) * 65 + nl], sl[(kc + 5) * 65 + nl]); w[3] = pk2(sl[(kc + 6) * 65 + nl], sl[(kc + 7) * 65 + nl]);
      *(u32x4*)(WT + (size_t)(REMAP ? remap_in(n) : n) * K + kt * 64 + kc) = w;
    }
    __syncthreads();
  }
}

DI void phase0(const Params& P, char* lds) {
  const int tid = threadIdx.x, wave = tid >> 6, lane = tid & 63;
  char* ws = P.ws;
  { float2* cs = (float2*)(ws + WS_MISC);
    for (int idx = blockIdx.x * 512 + tid; idx < 4096; idx += gridDim.x * 512) {
      const int pos = idx >> 5, fi = idx & 31;
      const float inv = exp2f(-(float)fi * (13.287712379549449f / 32.f));
      const float ang = (float)pos * inv;
      cs[idx] = make_float2(cosf(ang), sinf(ang));
    } }
  transpose_w<true>(P.w_in, 1024, INW, (bf16*)(ws + WS_WT_IN), (float*)lds);
  transpose_w<false>(P.w_br_att, 1024, 1024, (bf16*)(ws + WS_WT_BRA), (float*)lds);
  transpose_w<false>(P.w_br_dn, 1024, 1024, (bf16*)(ws + WS_WT_BRD), (float*)lds);
  transpose_w<false>(P.w_out, 1024, 1024, (bf16*)(ws + WS_WT_OUT), (float*)lds);
  transpose_w<false>(P.w_ple_gate, 1024, 1024, (bf16*)(ws + WS_WT_PG), (float*)lds);
  transpose_w<false>(P.w_ple_proj, 256, 1024, (bf16*)(ws + WS_WT_PP), (float*)lds);
  bf16* H = (bf16*)(ws + WS_H);
  for (int row = blockIdx.x * 8 + wave; row < M; row += gridDim.x * 8) {
    const float* xr = P.x + (size_t)row * DM;
    f32x4 v[4]; float ss = 0.f;
#pragma unroll
    for (int i = 0; i < 4; ++i) { v[i] = __builtin_nontemporal_load((const f32x4*)(xr + i * 256 + lane * 4)); ss += v[i][0] * v[i][0] + v[i][1] * v[i][1] + v[i][2] * v[i][2] + v[i][3] * v[i][3]; }
    ss = wave_sum(ss);
    const float rstd = rsqrtf(ss * (1.f / DM) + EPS);
#pragma unroll
    for (int i = 0; i < 4; ++i) {
      const f32x4 w = *(const f32x4*)(P.norm_pre + i * 256 + lane * 4);
      u32x2 o = {pk2(v[i][0] * rstd * w[0], v[i][1] * rstd * w[1]), pk2(v[i][2] * rstd * w[2], v[i][3] * rstd * w[3])};
      *(u32x2*)(H + (size_t)row * DM + i * 256 + lane * 4) = o;
    }
  }
}

DI void phase_pconv(const Params& P) {
  const int tid = threadIdx.x; char* ws = P.ws;
  bf16* PB = (bf16*)(ws + WS_PB);
  for (size_t i = (size_t)blockIdx.x * 512 + tid; i < (size_t)M * PLE / 8; i += (size_t)gridDim.x * 512) {
    const f32x4 a = __builtin_nontemporal_load((const f32x4*)(P.p + i * 8)), b = __builtin_nontemporal_load((const f32x4*)(P.p + i * 8 + 4));
    u32x4 o = {pk2(a[0], a[1]), pk2(a[2], a[3]), pk2(b[0], b[1]), pk2(b[2], b[3])};
    *(u32x4*)(PB + i * 8) = o;
  }
}

namespace pg8 {
#define PG8_LAS __attribute__((address_space(3)))
typedef unsigned short bf16_t;
typedef short bf16x8 __attribute__((ext_vector_type(8)));
typedef float f32x4 __attribute__((ext_vector_type(4)));
typedef unsigned u32x4 __attribute__((ext_vector_type(4)));
constexpr int BM = 256, BK = 64, HALF = 128, HTB = HALF * BK * 2  , STAGE_BYTES = 8 * HTB, NXCD = 8, WGM = 8;

__host__ __device__ __forceinline__ int lds_byte(int r, int c) { const int st = (r >> 4) * 2 + (c >> 5), rr = r & 15, cc = c & 31, ob = rr * 64 + cc * 2; return st * 1024 + (ob ^ (((ob >> 9) & 1) << 5)); }
__host__ __device__ __forceinline__ void stage_rc(int b, int& R, int& C) { const int st = b / 1024, sb = b % 1024, swz = sb ^ (((sb >> 9) & 1) << 5); R = (st >> 1) * 16 + swz / 64; C = (st & 1) * 32 + (swz % 64) / 2; }
__host__ __device__ __forceinline__ int perm32(int rho) { const int n = rho >> 4, i = rho & 15; return 8 * (i >> 2) + 4 * n + (i & 3); }

struct Unit { int pm, pn, kind; };
struct Gemm { const bf16_t* A; const bf16_t* Bt; int M, N, K; };

struct StaticOrder {
    int nM, nN, nwg, G, c;
    __host__ __device__ void init(int M, int N, int G_, int c_) { nM = M / BM; nN = N / BM; nwg = nM * nN; G = G_; c = c_; }
    __host__ __device__ bool next(int i, Unit& u) const {
        const long L = (long)i * G + c; if (L >= nwg) return false;
        int wgid = (int)L; { const int q = nwg / NXCD, r = nwg % NXCD, xcd = wgid % NXCD, off = wgid / NXCD; wgid = (xcd < r ? xcd * (q + 1) : r * (q + 1) + (xcd - r) * q) + off; }
        const int nig = WGM * nN, gid = wgid / nig, fm = gid * WGM, gsz = (nM - fm) < WGM ? (nM - fm) : WGM;
        u.pm = fm + ((wgid % nig) % gsz); u.pn = (wgid % nig) / gsz; u.kind = 0; return true;
    }
    __device__ __forceinline__ void ab(const Gemm& g, const Unit& u, size_t tstep, const char*& A, const char*& B) const { A = (const char*)g.A + (size_t)u.pm * tstep; B = (const char*)g.Bt + (size_t)u.pn * tstep; }
    __device__ __forceinline__ void a_ready(const Unit&) const {}
    __device__ __forceinline__ void done(const Unit&) const {}
};
template <class Epi, class Sched, bool ALIGN_EPI = false, bool SP2 = false>
__device__ __forceinline__ void gemm_phase(PG8_LAS unsigned char* lds, const Gemm g, const Sched& S, const Epi& E) {
    const int tid = threadIdx.x, wid = __builtin_amdgcn_readfirstlane(tid >> 6), lane = tid & 63, wr = wid >> 2, wc = wid & 3, fr = lane & 15, fq = lane >> 4;
    const int K = g.K, nt = K / BK;
    unsigned voffA[2], voffB[2];
#pragma unroll
    for (int i = 0; i < 2; ++i) { int R, C; stage_rc(tid * 16 + i * 8192, R, C); const int Rb = Epi::PERM ? ((R & ~31) + perm32(R & 31)) : R;
        voffA[i] = (unsigned)(R * K + C) * 2u; voffB[i] = (unsigned)(Rb * K + C) * 2u; }
    const size_t kstep = (size_t)(BK * 2);
    const size_t hstep = (size_t)HALF * K * 2;
    const size_t tstep = 2 * hstep;
    const unsigned ldsw = (unsigned)wid * 1024u;
    const int aoff = lds_byte(wr * 64 + fr, fq * 8), boff = lds_byte(wc * 32 + fr, fq * 8);
#define PG8_SA(b, h) (((b) * 2 + (h)) * HTB)
#define PG8_SB(b, h) ((4 + (b) * 2 + (h)) * HTB)
#define PG8_STAGE(bufoff, gbase, voff) do { _Pragma("unroll") for (int _i = 0; _i < 2; ++_i) \
        __builtin_amdgcn_global_load_lds((const unsigned*)((const char*)(gbase) + (voff)[_i]), (PG8_LAS unsigned*)(lds + (bufoff) + ldsw + _i * 8192), 16, 0, 0); } while (0)
#define PG8_LDA(dst, b, h) do { _Pragma("unroll") for (int m = 0; m < 4; ++m) _Pragma("unroll") for (int k = 0; k < 2; ++k) dst[m][k] = *(const PG8_LAS bf16x8*)(lds + PG8_SA(b, h) + aoff + m * 2048 + k * 1024); } while (0)
#define PG8_LDB(dst, b, h) do { _Pragma("unroll") for (int n = 0; n < 2; ++n) _Pragma("unroll") for (int k = 0; k < 2; ++k) dst[n][k] = *(const PG8_LAS bf16x8*)(lds + PG8_SB(b, h) + boff + n * 2048 + k * 1024); } while (0)
#define PG8_MMA(ai, bj, At, Bt) do { __builtin_amdgcn_s_setprio(1); _Pragma("unroll") for (int m = 0; m < 4; ++m) _Pragma("unroll") for (int n = 0; n < 2; ++n) _Pragma("unroll") for (int k = 0; k < 2; ++k) \
        acc[ai][bj][m][n] = __builtin_amdgcn_mfma_f32_16x16x32_bf16(Bt[n][k], At[m][k], acc[ai][bj][m][n], 0, 0, 0); __builtin_amdgcn_s_setprio(0); } while (0)
#define PG8_WAIT_V(n) asm volatile("s_waitcnt vmcnt(" #n ")" ::: "memory")
#define PG8_WAIT_L(n) asm volatile("s_waitcnt lgkmcnt(" #n ")" ::: "memory")
#define PG8_BAR __builtin_amdgcn_s_barrier()
#define PG8_SCHED __builtin_amdgcn_sched_barrier(0)
    Unit cur, nxt; int ui = 0;
    if (!S.next(0, cur)) return;
    f32x4 acc[2][2][4][2];
#pragma unroll
    for (int a = 0; a < 2; ++a)
#pragma unroll
        for (int b = 0; b < 2; ++b)
#pragma unroll
            for (int m = 0; m < 4; ++m)
#pragma unroll
                for (int n = 0; n < 2; ++n) acc[a][b][m][n] = (f32x4){0.f, 0.f, 0.f, 0.f};
    bf16x8 At[4][2], B0[2][2], B1[2][2];
    const char* cA; const char* cB; S.ab(g, cur, tstep, cA, cB);
    S.a_ready(cur);
    if constexpr (SP2) {
        PG8_STAGE(PG8_SB(0, 0), cB, voffB); PG8_STAGE(PG8_SB(0, 1), cB + hstep, voffB); PG8_STAGE(PG8_SA(0, 0), cA, voffA); PG8_STAGE(PG8_SA(0, 1), cA + hstep, voffA);
        if (wr == 1) PG8_BAR;
        PG8_WAIT_V(2); PG8_BAR;
        PG8_STAGE(PG8_SB(1, 0), cB + kstep, voffB); PG8_STAGE(PG8_SA(1, 0), cA + kstep, voffA); PG8_STAGE(PG8_SB(1, 1), cB + hstep + kstep, voffB);
        PG8_WAIT_V(6); PG8_BAR;
    } else {
        PG8_STAGE(PG8_SB(0, 0), cB, voffB); PG8_STAGE(PG8_SA(0, 0), cA, voffA); PG8_STAGE(PG8_SB(0, 1), cB + hstep, voffB); PG8_STAGE(PG8_SA(0, 1), cA + hstep, voffA);
        if (wr == 1) PG8_BAR;
        PG8_WAIT_V(4); PG8_BAR;
        PG8_STAGE(PG8_SB(1, 0), cB + kstep, voffB); PG8_STAGE(PG8_SA(1, 0), cA + kstep, voffA); PG8_STAGE(PG8_SB(1, 1), cB + hstep + kstep, voffB);
        PG8_WAIT_V(6); PG8_BAR;
    }
    for (;;) {
        const bool has_next = S.next(ui + 1, nxt);
        const char* nA = cA; const char* nB = cB; if (has_next) S.ab(g, nxt, tstep, nA, nB);
        for (int t = 0; t < nt; t += 2) {
            const bool last = (t == nt - 2);
            const char* a1 = cA + (size_t)(t + 1) * kstep;
            const char* a2 = last ? nA : cA + (size_t)(t + 2) * kstep; const char* b2 = last ? nB : cB + (size_t)(t + 2) * kstep;
            const char* a3 = a2 + kstep; const char* b3 = b2 + kstep;
            if (last && has_next) S.a_ready(nxt);
            if constexpr (SP2) {
            PG8_LDB(B0, 0, 0); PG8_LDB(B1, 0, 1); PG8_SCHED; PG8_LDA(At, 0, 0); PG8_STAGE(PG8_SA(1, 1), a1 + hstep, voffA);
            PG8_WAIT_V(8); PG8_WAIT_L(0); PG8_BAR; PG8_MMA(0, 0, At, B0); PG8_MMA(0, 1, At, B1); PG8_BAR; PG8_SCHED;
            PG8_LDA(At, 0, 1); PG8_STAGE(PG8_SB(0, 0), b2, voffB); PG8_STAGE(PG8_SB(0, 1), b2 + hstep, voffB); PG8_STAGE(PG8_SA(0, 0), a2, voffA);
            PG8_WAIT_V(8); PG8_WAIT_L(0); PG8_BAR; PG8_MMA(1, 0, At, B0); PG8_MMA(1, 1, At, B1); PG8_BAR; PG8_SCHED;
            PG8_LDB(B0, 1, 0); PG8_LDB(B1, 1, 1); PG8_SCHED; PG8_LDA(At, 1, 0); PG8_STAGE(PG8_SA(0, 1), a2 + hstep, voffA);
            PG8_WAIT_V(8); PG8_WAIT_L(0); PG8_BAR; PG8_MMA(0, 0, At, B0); PG8_MMA(0, 1, At, B1); PG8_BAR; PG8_SCHED;
            PG8_LDA(At, 1, 1); PG8_STAGE(PG8_SB(1, 0), b3, voffB); PG8_STAGE(PG8_SB(1, 1), b3 + hstep, voffB); PG8_STAGE(PG8_SA(1, 0), a3, voffA);
            PG8_WAIT_V(8); PG8_WAIT_L(0); PG8_BAR; PG8_MMA(1, 0, At, B0); PG8_MMA(1, 1, At, B1); PG8_BAR; PG8_SCHED;
            } else {
            PG8_LDB(B0, 0, 0); PG8_SCHED; PG8_LDA(At, 0, 0); PG8_STAGE(PG8_SA(1, 1), a1 + hstep, voffA);
            PG8_WAIT_L(8); PG8_BAR; PG8_WAIT_L(0); PG8_MMA(0, 0, At, B0); PG8_BAR; PG8_SCHED;
            PG8_LDB(B1, 0, 1); PG8_STAGE(PG8_SB(0, 0), b2, voffB);
            PG8_BAR; PG8_WAIT_L(0); PG8_MMA(0, 1, At, B1); PG8_BAR;
            PG8_LDA(At, 0, 1); PG8_STAGE(PG8_SA(0, 0), a2, voffA);
            PG8_BAR; PG8_WAIT_L(0); PG8_MMA(1, 0, At, B0); PG8_BAR; PG8_SCHED;
            PG8_STAGE(PG8_SB(0, 1), b2 + hstep, voffB);
            PG8_WAIT_V(6); PG8_BAR; PG8_MMA(1, 1, At, B1); PG8_BAR;
            PG8_LDB(B0, 1, 0); PG8_SCHED; PG8_LDA(At, 1, 0); PG8_STAGE(PG8_SA(0, 1), a2 + hstep, voffA);
            PG8_WAIT_L(8); PG8_BAR; PG8_WAIT_L(0); PG8_MMA(0, 0, At, B0); PG8_BAR; PG8_SCHED;
            PG8_LDB(B1, 1, 1); PG8_STAGE(PG8_SB(1, 0), b3, voffB);
            PG8_BAR; PG8_WAIT_L(0); PG8_MMA(0, 1, At, B1); PG8_BAR;
            PG8_LDA(At, 1, 1); PG8_STAGE(PG8_SA(1, 0), a3, voffA);
            PG8_BAR; PG8_WAIT_L(0); PG8_MMA(1, 0, At, B0); PG8_BAR; PG8_SCHED;
            PG8_STAGE(PG8_SB(1, 1), b3 + hstep, voffB);
            PG8_WAIT_V(6); PG8_BAR; PG8_MMA(1, 1, At, B1); PG8_BAR;
            }
        }
        if constexpr (ALIGN_EPI) { if (wr == 0) PG8_BAR; }
        if constexpr (!Epi::AFTER_DRAIN) { E(acc, cur, wr, wc, fr, fq); S.done(cur); }
        if (!has_next) break;
#pragma unroll
        for (int a = 0; a < 2; ++a)
#pragma unroll
            for (int b = 0; b < 2; ++b)
#pragma unroll
                for (int m = 0; m < 4; ++m)
#pragma unroll
                    for (int n = 0; n < 2; ++n) acc[a][b][m][n] = (f32x4){0.f, 0.f, 0.f, 0.f};
        cur = nxt; cA = nA; cB = nB; ++ui;
        if constexpr (ALIGN_EPI) { if (wr == 1) PG8_BAR; }
    }
    PG8_WAIT_V(0);
    if constexpr (!ALIGN_EPI) { if (wr == 0) PG8_BAR; }
    PG8_BAR;
    if constexpr (Epi::AFTER_DRAIN) { E.fused(acc, cur, wr, wc, fr, fq, lds, wid, lane); S.done(cur); }
#undef PG8_SA
#undef PG8_SB
#undef PG8_STAGE
#undef PG8_LDA
#undef PG8_LDB
#undef PG8_MMA
#undef PG8_WAIT_V
#undef PG8_WAIT_L
#undef PG8_BAR
#undef PG8_SCHED
}


}

constexpr int XCH_OFF = 131072;
DI unsigned lo16f(unsigned w) { return w << 16; }
DI void unpack8(const u32x4 w, float* o) {
#pragma unroll
  for (int e = 0; e < 4; ++e) { o[2 * e] = __uint_as_float(w[e] << 16); o[2 * e + 1] = __uint_as_float(w[e] & 0xffff0000u); }
}
DI u32x4 pack8(const float* v) { return u32x4{pk2(v[0], v[1]), pk2(v[2], v[3]), pk2(v[4], v[5]), pk2(v[6], v[7])}; }
#define XCH_IDX(wr, ai, m, bj, fr) ((((((wr) * 2 + (ai)) * 4 + (m)) * 2 + (bj)) * 16 + (fr)) * 4)

struct EpiG1 {
  static constexpr bool PERM = true, AFTER_DRAIN = false;
  char* ws; const float* q_norm; const float* k_norm; const float* a_log; const float* dt_bias; float* xch;
  DI void operator()(const pg8::f32x4 (&acc)[2][2][4][2], const pg8::Unit& u, int wr, int wc, int fr, int fq) const {
    const int pn = u.pn, row0 = u.pm * 256 + wr * 64 + fr, c0 = wc * 32 + fq * 8;
    if (pn < 5) {
#pragma unroll
      for (int ai = 0; ai < 2; ++ai)
#pragma unroll
        for (int m = 0; m < 4; ++m)
#pragma unroll
          for (int bj = 0; bj < 2; ++bj) {
            const pg8::f32x4 a = acc[ai][bj][m][0], b = acc[ai][bj][m][1];
            float s = a[0] * a[0] + a[1] * a[1] + a[2] * a[2] + a[3] * a[3] + b[0] * b[0] + b[1] * b[1] + b[2] * b[2] + b[3] * b[3];
            s += __shfl_xor(s, 16); s += __shfl_xor(s, 32);
            if (fq == 0) xch[XCH_IDX(wr, ai, m, bj, fr) + wc] = s;
          }
      asm volatile("s_waitcnt lgkmcnt(0)" ::: "memory");
      __builtin_amdgcn_s_barrier();
      const float* nw = pn < 4 ? q_norm : k_norm;
      const f32x4 w0 = *(const f32x4*)(nw + c0), w1 = *(const f32x4*)(nw + c0 + 4);
      const float2* cs = (const float2*)(ws + WS_MISC);
#pragma unroll
      for (int ai = 0; ai < 2; ++ai)
#pragma unroll
        for (int m = 0; m < 4; ++m) {
          const int row = row0 + ai * 128 + m * 16, t = row & (SEQ - 1);
          const int pos = (wc < 2) ? (t >> 6) : (t & 63);
          const float2* cp = cs + pos * 32 + ((c0 >> 1) & 31);
          const f32x4 cs0 = *(const f32x4*)cp, cs1 = *(const f32x4*)(cp + 2);
#pragma unroll
          for (int bj = 0; bj < 2; ++bj) {
            const f32x4 ps = *(const f32x4*)(xch + XCH_IDX(wr, ai, m, bj, fr));
            const float rstd = rsqrtf((ps[0] + ps[1] + ps[2] + ps[3]) * (1.f / 128.f) + EPS);
            const pg8::f32x4 a = acc[ai][bj][m][0], b = acc[ai][bj][m][1];
            float v[8] = {a[0] * rstd * w0[0], a[1] * rstd * w0[1], a[2] * rstd * w0[2], a[3] * rstd * w0[3],
                          b[0] * rstd * w1[0], b[1] * rstd * w1[1], b[2] * rstd * w1[2], b[3] * rstd * w1[3]};
            float o[8];
            o[0] = v[0] * cs0[0] - v[1] * cs0[1]; o[1] = v[0] * cs0[1] + v[1] * cs0[0];
            o[2] = v[2] * cs0[2] - v[3] * cs0[3]; o[3] = v[2] * cs0[3] + v[3] * cs0[2];
            o[4] = v[4] * cs1[0] - v[5] * cs1[1]; o[5] = v[4] * cs1[1] + v[5] * cs1[0];
            o[6] = v[6] * cs1[2] - v[7] * cs1[3]; o[7] = v[6] * cs1[3] + v[7] * cs1[2];
            bf16* dst = pn < 4 ? (bf16*)(ws + WS_QA) + (size_t)row * 1024 + (2 * pn + bj) * 128 + c0 : (bf16*)(ws + WS_KA) + (size_t)row * 256 + bj * 128 + c0;
            *(u32x4*)dst = pack8(o);
          }
          asm volatile("" ::: "memory");
        }
    } else if (pn < 18) {
#pragma unroll
      for (int ai = 0; ai < 2; ++ai)
#pragma unroll
        for (int m = 0; m < 4; ++m) {
          const int row = row0 + ai * 128 + m * 16, c64 = row & 63;
#pragma unroll
          for (int bj = 0; bj < 2; ++bj) {
            const pg8::f32x4 a = acc[ai][bj][m][0], b = acc[ai][bj][m][1];
            const u32x4 w = {pk2(a[0], a[1]), pk2(a[2], a[3]), pk2(b[0], b[1]), pk2(b[2], b[3])};
            if (pn == 5) *(u32x4*)((bf16*)(ws + WS_VA) + (size_t)row * 256 + bj * 128 + c0) = w;
            else {
              const int col = (pn - 6) * 256 + bj * 128 + c0;
              *(u32x4*)((bf16*)(ws + WS_RAW) + (size_t)row * 3072 + col) = w;
              if (c64 < 2 || c64 >= 62) *(u32x4*)((bf16*)(ws + WS_HALO) + ((size_t)(row >> 6) * 4 + (c64 < 2 ? c64 : c64 - 60)) * 3072 + col) = w;
            }
          }
          asm volatile("" ::: "memory");
        }
    } else if (wc == 0) {
      float* GB = (float*)(ws + WS_GB);
      int fqq = fq; asm volatile("" : "+v"(fqq));
#pragma unroll
      for (int n = 0; n < 2; ++n) {
        const int col = fqq * 8 + n * 4;
        f32x4 al = {0.f, 0.f, 0.f, 0.f}, dtb = {0.f, 0.f, 0.f, 0.f};
        if (col >= 16) { const f32x4 t = *(const f32x4*)(a_log + col - 16); al = f32x4{__expf(t[0]), __expf(t[1]), __expf(t[2]), __expf(t[3])}; dtb = *(const f32x4*)(dt_bias + col - 16); }
#pragma unroll
        for (int ai = 0; ai < 2; ++ai)
#pragma unroll
          for (int m = 0; m < 4; ++m) {
            const int row = row0 + ai * 128 + m * 16;
            const pg8::f32x4 a = acc[ai][0][m][n];
            f32x4 o;
#pragma unroll
            for (int e = 0; e < 4; ++e) {
              if (col < 16) o[e] = sigmoidf_(a[e]);
              else { const float z = a[e] + dtb[e]; const float sp = z > 20.f ? z : log1pf(__expf(z)); o[e] = -al[e] * sp; }
            }
            *(f32x4*)(GB + (size_t)row * 32 + col) = o;
          }
      }
    }
  }
};

struct EpiG3 {
  static constexpr bool PERM = true, AFTER_DRAIN = false;
  bf16* QA; bf16* OF; const bf16* OB; const float* dn_norm; float* xch; const bf16* PO; const float* ML;
  DI void operator()(const pg8::f32x4 (&acc)[2][2][4][2], const pg8::Unit& u, int wr, int wc, int fr, int fq) const {
    const int pn = u.pn, row0 = u.pm * 256 + wr * 64 + fr, c0 = wc * 32 + fq * 8;
    if (pn < 4) {
#pragma unroll
      for (int ai = 0; ai < 2; ++ai)
#pragma unroll
        for (int m = 0; m < 4; ++m)
#pragma unroll
          for (int bj = 0; bj < 2; ++bj) {
            const int row = row0 + ai * 128 + m * 16;
            bf16* p = QA + (size_t)row * 1024 + pn * 256 + bj * 128 + c0;
            float o[8];
            if (pn == 3 && u.pm >= 32) {
              const int pc0 = (bj * 32 + ((row - SEQ) >> 8)) * 4, rr = row & 255;
              float mq[4], lq[4], mmax = -3.0e38f;
#pragma unroll
              for (int q = 0; q < 4; ++q) { const float2 t = *(const float2*)(ML + ((size_t)(pc0 + q) * 256 + rr) * 2); mq[q] = t.x; lq[q] = t.y; mmax = fmaxf(mmax, t.x); }
              float wsum = 0.f;
#pragma unroll
              for (int e = 0; e < 8; ++e) o[e] = 0.f;
#pragma unroll
              for (int q = 0; q < 4; ++q) {
                const float wq = __builtin_amdgcn_exp2f((mq[q] - mmax) * (0.088388347648318440f * 1.4426950408889634f)) * lq[q];
                float x[8]; unpack8(*(const u32x4*)(PO + ((size_t)(pc0 + q) * 256 + rr) * 128 + c0), x);
#pragma unroll
                for (int e = 0; e < 8; ++e) o[e] += wq * x[e];
                wsum += wq;
              }
              const float inv = 1.f / wsum;
#pragma unroll
              for (int e = 0; e < 8; ++e) o[e] *= inv;
            } else unpack8(*(const u32x4*)p, o);
            const pg8::f32x4 a = acc[ai][bj][m][0], b = acc[ai][bj][m][1];
            o[0] *= siluf_(a[0]); o[1] *= siluf_(a[1]); o[2] *= siluf_(a[2]); o[3] *= siluf_(a[3]);
            o[4] *= siluf_(b[0]); o[5] *= siluf_(b[1]); o[6] *= siluf_(b[2]); o[7] *= siluf_(b[3]);
            *(u32x4*)p = pack8(o);
          }
    } else {
      const f32x4 w0 = *(const f32x4*)(dn_norm + c0), w1 = *(const f32x4*)(dn_norm + c0 + 4);
#pragma unroll
      for (int ai = 0; ai < 2; ++ai)
#pragma unroll
        for (int m = 0; m < 4; ++m)
#pragma unroll
          for (int bj = 0; bj < 2; ++bj) {
            const size_t idx = (size_t)(row0 + ai * 128 + m * 16) * 1024 + (pn - 4) * 256 + bj * 128 + c0;
            float x[8], y[8]; unpack8(*(const u32x4*)(OF + idx), x); unpack8(*(const u32x4*)(OB + idx), y);
            float s = 0.f;
#pragma unroll
            for (int e = 0; e < 8; ++e) { x[e] += y[e]; s += x[e] * x[e]; }
            s += __shfl_xor(s, 16); s += __shfl_xor(s, 32);
            if (fq == 0) xch[XCH_IDX(wr, ai, m, bj, fr) + wc] = s;
          }
      asm volatile("s_waitcnt lgkmcnt(0)" ::: "memory");
      __builtin_amdgcn_s_barrier();
#pragma unroll
      for (int ai = 0; ai < 2; ++ai)
#pragma unroll
        for (int m = 0; m < 4; ++m)
#pragma unroll
          for (int bj = 0; bj < 2; ++bj) {
            const size_t idx = (size_t)(row0 + ai * 128 + m * 16) * 1024 + (pn - 4) * 256 + bj * 128 + c0;
            float x[8], y[8]; unpack8(*(const u32x4*)(OF + idx), x); unpack8(*(const u32x4*)(OB + idx), y);
            const f32x4 ps = *(const f32x4*)(xch + XCH_IDX(wr, ai, m, bj, fr));
            const float rstd = rsqrtf((ps[0] + ps[1] + ps[2] + ps[3]) * (1.f / 128.f) + EPS);
            const pg8::f32x4 a = acc[ai][bj][m][0], b = acc[ai][bj][m][1];
            float o[8];
            o[0] = (x[0] + y[0]) * rstd * w0[0] * siluf_(a[0]); o[1] = (x[1] + y[1]) * rstd * w0[1] * siluf_(a[1]);
            o[2] = (x[2] + y[2]) * rstd * w0[2] * siluf_(a[2]); o[3] = (x[3] + y[3]) * rstd * w0[3] * siluf_(a[3]);
            o[4] = (x[4] + y[4]) * rstd * w1[0] * siluf_(b[0]); o[5] = (x[5] + y[5]) * rstd * w1[1] * siluf_(b[1]);
            o[6] = (x[6] + y[6]) * rstd * w1[2] * siluf_(b[2]); o[7] = (x[7] + y[7]) * rstd * w1[3] * siluf_(b[3]);
            *(u32x4*)(OF + idx) = pack8(o);
          }
    }
  }
};

template <int MODE> struct EpiEW {
  static constexpr bool PERM = true, AFTER_DRAIN = false;
  bf16* ob; float* of; const bf16* in1;
  DI void operator()(const pg8::f32x4 (&acc)[2][2][4][2], const pg8::Unit& u, int wr, int wc, int fr, int fq) const {
    const int row0 = u.pm * 256 + wr * 64 + fr, c0 = u.pn * 256 + wc * 32 + fq * 8;
#pragma unroll
    for (int ai = 0; ai < 2; ++ai)
#pragma unroll
      for (int m = 0; m < 4; ++m)
#pragma unroll
        for (int bj = 0; bj < 2; ++bj) {
          const size_t idx = (size_t)(row0 + ai * 128 + m * 16) * 1024 + bj * 128 + c0;
          const pg8::f32x4 a = acc[ai][bj][m][0], b = acc[ai][bj][m][1];
          float v[8] = {a[0], a[1], a[2], a[3], b[0], b[1], b[2], b[3]};
          float g[8];
          if (MODE == 1 || MODE == 2 || MODE == 5 || MODE == 6) unpack8(*(const u32x4*)(in1 + idx), g);
          if (MODE == 0) {
#pragma unroll
            for (int e = 0; e < 8; ++e) v[e] = sigmoidf_(v[e]);
          } else if (MODE == 1) {
#pragma unroll
            for (int e = 0; e < 8; ++e) v[e] *= g[e];
          } else if (MODE == 2) {
            float p[8]; unpack8(*(const u32x4*)(ob + idx), p);
#pragma unroll
            for (int e = 0; e < 8; ++e) v[e] = p[e] + g[e] * v[e];
          } else if (MODE == 5 || MODE == 6) {
#pragma unroll
            for (int e = 0; e < 8; ++e) v[e] = sigmoidf_(v[e]) * g[e];
          }
          if (MODE == 3 || MODE == 5) { *(f32x4*)(of + idx) = f32x4{v[0], v[1], v[2], v[3]}; *(f32x4*)(of + idx + 4) = f32x4{v[4], v[5], v[6], v[7]}; }
          else *(u32x4*)(ob + idx) = pack8(v);
        }
  }
};

template <class Epi, bool ALIGN> DI void run_gemm(char* lds, const bf16* A, const bf16* Bt, int N, int K, const Epi& E) {
  pg8::Gemm g{A, Bt, M, N, K};
  pg8::StaticOrder S; S.init(M, N, (int)gridDim.x, (int)blockIdx.x);
  pg8::gemm_phase<Epi, pg8::StaticOrder, ALIGN, true>((PG8_LAS unsigned char*)lds, g, S, E);
}

constexpr int R_G3 = 4864, R_GA = 6912, R_GD = 7936;
DI void phase_g1(const Params& P, char* lds) {
  char* ws = P.ws;
  EpiG1 E{ws, P.q_norm, P.k_norm, P.a_log, P.dt_bias, (float*)(lds + XCH_OFF)};
  run_gemm<EpiG1, true>(lds, (const bf16*)(ws + WS_H), (const bf16*)(ws + WS_WT_IN), 4864, DM, E);
}
DI void phase_g3(const Params& P, char* lds) {
  char* ws = P.ws;
  EpiG3 E{(bf16*)(ws + WS_QA), (bf16*)P.out, (const bf16*)P.out + (size_t)M * DM, P.dn_norm, (float*)(lds + XCH_OFF), (const bf16*)(ws + WS_PB), (const float*)(ws + WS_ML)};
  run_gemm<EpiG3, true>(lds, (const bf16*)(ws + WS_H), (const bf16*)(ws + WS_WT_IN) + (size_t)R_G3 * DM, 2048, DM, E);
}
struct ChainOrder4 {
  pg8::StaticOrder so; const char* ws; const char* out;
  DI bool next(int i, pg8::Unit& u) const { if (!so.next(i >> 2, u)) return false; u.kind = i & 3; return true; }
  DI void ab(const pg8::Gemm&, const pg8::Unit& u, size_t tstep, const char*& A, const char*& B) const {
    size_t oa = WS_H; if (u.kind == 1) oa = WS_QA;
    size_t ob = WS_WT_IN + (size_t)R_GA * DM * 2; if (u.kind == 1) ob = WS_WT_BRA; if (u.kind == 2) ob = WS_WT_IN + (size_t)R_GD * DM * 2; if (u.kind == 3) ob = WS_WT_BRD;
    const char* a = ws + oa; if (u.kind == 3) a = out;
    A = a + (size_t)u.pm * tstep; B = ws + ob + (size_t)u.pn * tstep;
  }
  DI void a_ready(const pg8::Unit&) const {}
  DI void done(const pg8::Unit&) const {}
};
struct EpiG4 {
  static constexpr bool PERM = true, AFTER_DRAIN = false;
  bf16* T1; bf16* MX;
  DI void operator()(const pg8::f32x4 (&acc)[2][2][4][2], const pg8::Unit& u, int wr, int wc, int fr, int fq) const {
    const int row0 = u.pm * 256 + wr * 64 + fr, c0 = u.pn * 256 + wc * 32 + fq * 8, kind = u.kind;
#pragma unroll
    for (int ai = 0; ai < 2; ++ai)
#pragma unroll
      for (int m = 0; m < 4; ++m) {
#pragma unroll
        for (int bj = 0; bj < 2; ++bj) {
          const size_t idx = (size_t)(row0 + ai * 128 + m * 16) * 1024 + bj * 128 + c0;
          const pg8::f32x4 a = acc[ai][bj][m][0], b = acc[ai][bj][m][1];
          float v[8] = {a[0], a[1], a[2], a[3], b[0], b[1], b[2], b[3]};
          if ((kind & 1) == 0) {
#pragma unroll
            for (int e = 0; e < 8; ++e) v[e] = sigmoidf_(v[e]);
            *(u32x4*)(T1 + idx) = pack8(v);
          } else {
            float g[8]; unpack8(*(const u32x4*)(T1 + idx), g);
#pragma unroll
            for (int e = 0; e < 8; ++e) v[e] *= g[e];
            if (kind == 3) { float p[8]; unpack8(*(const u32x4*)(MX + idx), p);
#pragma unroll
              for (int e = 0; e < 8; ++e) v[e] += p[e]; }
            *(u32x4*)(MX + idx) = pack8(v);
          }
        }
        asm volatile("" ::: "memory");
      }
  }
};
DI void phase_g4(const Params& P, char* lds) {
  char* ws = P.ws;
  const bf16* WT = (const bf16*)(ws + WS_WT_IN);
  ChainOrder4 S; S.so.init(M, 1024, (int)gridDim.x, (int)blockIdx.x);
  S.ws = ws; S.out = (const char*)P.out;
  EpiG4 E{(bf16*)(ws + WS_X1B), (bf16*)(ws + WS_MIXIN)};
  pg8::Gemm g{(const bf16*)(ws + WS_H), WT + (size_t)R_GA * DM, M, 1024, DM};
  pg8::gemm_phase<EpiG4, ChainOrder4, true, true>((PG8_LAS unsigned char*)lds, g, S, E);
}
DI void phase_g5(const Params& P, char* lds) {
  char* ws = P.ws;
  EpiEW<4> E{(bf16*)(ws + WS_MIXO), nullptr, nullptr};
  run_gemm<EpiEW<4>, true>(lds, (const bf16*)(ws + WS_MIXIN), (const bf16*)(ws + WS_WT_OUT), 1024, DM, E);
}
DI void phase_g6(const Params& P, char* lds) {
  char* ws = P.ws;
  bf16* T1 = (bf16*)(ws + WS_MIXIN);
  { EpiEW<4> E{T1, nullptr, nullptr}; run_gemm<EpiEW<4>, true>(lds, (const bf16*)(ws + WS_PB), (const bf16*)(ws + WS_WT_PP), 1024, PLE, E); }
  { EpiEW<6> E{(bf16*)(ws + WS_MIXO), nullptr, T1}; run_gemm<EpiEW<6>, true>(lds, (const bf16*)(ws + WS_X1B), (const bf16*)(ws + WS_WT_PG), 1024, DM, E); }
}

DI bf16x8 ldfragP(const char* base, int stride, int row, int kbase, int hi) {
  const char* p = base + row * stride + (kbase + 4 * hi) * 2;
  const s16x4 lo = *(const s16x4*)p, h4 = *(const s16x4*)(p + 16);
  return __builtin_shufflevector(lo, h4, 0, 1, 2, 3, 4, 5, 6, 7);
}
template <int S> DI bf16x8 packacc(const f32x16& x) {
  u32x4 w = {pk2(x[8 * S], x[8 * S + 1]), pk2(x[8 * S + 2], x[8 * S + 3]), pk2(x[8 * S + 4], x[8 * S + 5]), pk2(x[8 * S + 6], x[8 * S + 7])};
  return __builtin_bit_cast(bf16x8, w);
}

DI void phase_conv(const Params& P, char* lds) {
  const int tid = threadIdx.x;
  char* ws = P.ws;
  bf16* RAW = (bf16*)(ws + WS_RAW); const bf16* HALO = (const bf16*)(ws + WS_HALO);
  float* ssp = (float*)lds;
  float* srn = (float*)(lds + 8192);
  const int cg = tid % 48, strip = tid / 48;
  const int x = cg >> 4, c8 = (cg & 15) * 8;
  for (int item = blockIdx.x; item < 2048; item += gridDim.x) {
    const int h = item & 7, chunk = item >> 3, n = chunk & 127;
    float y[8][8];
    if (tid < 384) {
      const int col = x * 1024 + h * 128 + c8;
      u32x4 xr[12];
#pragma unroll
      for (int i = 0; i < 12; ++i) {
        const int r = strip * 8 - 2 + i;
        const bf16* src;
        bool ok = true;
        if (r < 0) { ok = n > 0; src = HALO + ((size_t)(chunk - 1) * 4 + 4 + r) * 3072 + col; }
        else if (r >= 64) { ok = n < 127; src = HALO + ((size_t)(chunk + 1) * 4 + (r - 64)) * 3072 + col; }
        else src = RAW + ((size_t)chunk * 64 + r) * 3072 + col;
        xr[i] = ok ? *(const u32x4*)src : u32x4{0u, 0u, 0u, 0u};
      }
#pragma unroll
      for (int rr = 0; rr < 8; ++rr)
#pragma unroll
        for (int e = 0; e < 8; ++e) y[rr][e] = 0.f;
#pragma unroll
      for (int j = 0; j < 5; ++j) {
        const f32x4 wa = *(const f32x4*)(P.conv_w + j * 3072 + col), wb = *(const f32x4*)(P.conv_w + j * 3072 + col + 4);
#pragma unroll
        for (int rr = 0; rr < 8; ++rr) {
          const u32x4 xv = xr[rr + j];
          y[rr][0] += wa[0] * __uint_as_float(xv[0] << 16); y[rr][1] += wa[1] * __uint_as_float(xv[0] & 0xffff0000u);
          y[rr][2] += wa[2] * __uint_as_float(xv[1] << 16); y[rr][3] += wa[3] * __uint_as_float(xv[1] & 0xffff0000u);
          y[rr][4] += wb[0] * __uint_as_float(xv[2] << 16); y[rr][5] += wb[1] * __uint_as_float(xv[2] & 0xffff0000u);
          y[rr][6] += wb[2] * __uint_as_float(xv[3] << 16); y[rr][7] += wb[3] * __uint_as_float(xv[3] & 0xffff0000u);
        }
      }
#pragma unroll
      for (int rr = 0; rr < 8; ++rr) {
        float ss = 0.f;
#pragma unroll
        for (int e = 0; e < 8; ++e) { y[rr][e] = siluf_(y[rr][e]); ss += y[rr][e] * y[rr][e]; }
        if (x < 2) ssp[(x * 64 + strip * 8 + rr) * 16 + (cg & 15)] = ss;
      }
    }
    __syncthreads();
    if (tid < 128) {
      float ss = 0.f;
#pragma unroll
      for (int i = 0; i < 16; ++i) ss += ssp[tid * 16 + i];
      srn[tid] = rsqrtf(ss + EPS) * (tid < 64 ? 0.08838834764831845f : 1.f);
    }
    __syncthreads();
    if (tid < 384) {
      const int col = x * 1024 + h * 128 + c8;
#pragma unroll
      for (int rr = 0; rr < 8; ++rr) {
        const int row = strip * 8 + rr;
        const float sc = x < 2 ? srn[x * 64 + row] : 1.f;
        u32x4 o = {pk2(y[rr][0] * sc, y[rr][1] * sc), pk2(y[rr][2] * sc, y[rr][3] * sc), pk2(y[rr][4] * sc, y[rr][5] * sc), pk2(y[rr][6] * sc, y[rr][7] * sc)};
        *(u32x4*)(RAW + ((size_t)chunk * 64 + row) * 3072 + col) = o;
      }
    }
    __syncthreads();
  }
}

constexpr int D1_WAVE_LDS = 17408;
DI void phase_d1(const Params& P, char* lds) {
  const int tid = threadIdx.x, lane = tid & 63, r32 = lane & 31, hi = lane >> 5;
  const int wave = __builtin_amdgcn_readfirstlane(tid >> 6);
  char* ws = P.ws;
  const bf16* RAW = (const bf16*)(ws + WS_RAW); const float* GB = (const float*)(ws + WS_GB); bf16* TM = (bf16*)(ws + WS_TM);
  char* wl = lds + wave * D1_WAVE_LDS;
  float* sG = (float*)(wl + 16896); float* sB = sG + 64;
  for (int item = blockIdx.x * 8 + wave; item < 4096; item += gridDim.x * 8) {
    const int n = item & 127, dir = (item >> 7) & 1, h = (item >> 8) & 7, b = item >> 11;
    const int pos = n * 64 + lane, t = dir ? (SEQ - 1 - pos) : pos;
    const size_t m = (size_t)b * SEQ + t;
    const float beta = GB[m * 32 + dir * 8 + h];
    float G = GB[m * 32 + 16 + dir * 8 + h];
#pragma unroll
    for (int o = 1; o < 64; o <<= 1) { const float v = __shfl_up(G, o); if (lane >= o) G += v; }
    { const bf16* rk = RAW + m * 3072 + 1024 + h * 128;
#pragma unroll
      for (int ch = 0; ch < 16; ++ch) {
        const u32x4 xv = *(const u32x4*)(rk + ch * 8);
        *(u32x2*)(wl + lane * 264 + ch * 16) = u32x2{xv[0], xv[1]}; *(u32x2*)(wl + lane * 264 + ch * 16 + 8) = u32x2{xv[2], xv[3]};
      } }
    sG[lane] = G; sB[lane] = beta;
    ((float*)(ws + WS_GC))[(size_t)item * 64 + lane] = G;
    f32x16 c00 = {}, c10 = {}, c11 = {};
#pragma unroll
    for (int s = 0; s < 8; ++s) {
      const bf16x8 f0 = ldfragP(wl, 264, r32, s * 16, hi), f1 = ldfragP(wl, 264, 32 + r32, s * 16, hi);
      c00 = MFMA(f0, f0, c00); c10 = MFMA(f1, f0, c10); c11 = MFMA(f1, f1, c11);
    }
    float* L = (float*)wl;
    { const float Gj0 = sG[r32], Gj1 = sG[32 + r32];
      const float* sG4 = sG + 4 * hi; const float* sB4 = sB + 4 * hi; float* L4 = L + (4 * hi) * 64 + r32;
#pragma unroll
      for (int r = 0; r < 16; ++r) {
        const float bi0 = sB4[CRC(r)], bi1 = sB4[32 + CRC(r)], Gi0 = sG4[CRC(r)], Gi1 = sG4[32 + CRC(r)];
        const float l00 = (r32 < 4 * hi + CRC(r)) ? bi0 * c00[r] * __expf(Gi0 - Gj0) : 0.f;
        const float l10 = bi1 * c10[r] * __expf(Gi1 - Gj0);
        const float l11 = (r32 < 4 * hi + CRC(r)) ? bi1 * c11[r] * __expf(Gi1 - Gj1) : 0.f;
        L4[CRC(r) * 64] = l00; L4[(32 + CRC(r)) * 64] = l10; L4[(32 + CRC(r)) * 64 + 32] = l11;
      } }
    float tc[64];
#pragma unroll
    for (int i = 0; i < 64; ++i) {
      float a = (lane == i) ? 1.f : 0.f;
#pragma unroll
      for (int j4 = 0; j4 < (i + 3) / 4; ++j4) {
        const f32x4 l = *(const f32x4*)(L + i * 64 + j4 * 4);
#pragma unroll
        for (int e = 0; e < 4; ++e) if (j4 * 4 + e < i) a -= l[e] * tc[j4 * 4 + e];
      }
      tc[i] = a;
    }
    bf16* To = TM + (size_t)item * 4096;
#pragma unroll
    for (int i = 0; i < 64; ++i) To[i * 64 + lane] = f2bf(tc[i]);
  }
}

constexpr int SB_QH = 0, SB_KH = 16896, SB_VV = 33792, SB_TT = 50176, SB_G = 58880, SB_B = 59136, SB_E1 = 59392, SB_E2 = 59648, SB_SIZE = 59904, SC_AQ = 2 * SB_SIZE;
typedef __attribute__((address_space(3))) const char* lds_cptr;
typedef short v4i16_t __attribute__((ext_vector_type(4)));
DI s16x4 vtr(lds_cptr p) { return __builtin_bit_cast(s16x4, __builtin_amdgcn_ds_read_tr16_b64_v4i16((__attribute__((address_space(3))) v4i16_t*)p)); }
DI bf16x8 ldfragT(lds_cptr tp) { const s16x4 lo = vtr(tp), h4 = vtr(tp + 8 * 264); return __builtin_shufflevector(lo, h4, 0, 1, 2, 3, 4, 5, 6, 7); }

DI void delta_chain(const Params& P, char* lds, int chain) {
  int tid_ = threadIdx.x; asm volatile("" : "+v"(tid_));
  const int tid = tid_, lane = tid & 63, r32 = lane & 31, hi = lane >> 5;
  const int wave = __builtin_amdgcn_readfirstlane(tid >> 6);
  const int dir = chain & 1, h = (chain >> 1) & 7, b = chain >> 4;
  char* ws = P.ws;
  const bf16* RAW = (const bf16*)(ws + WS_RAW) + (size_t)b * SEQ * 3072 + h * 128;
  const float* GB = (const float*)(ws + WS_GB) + (size_t)b * SEQ * 32;
  const float* GC = (const float*)(ws + WS_GC) + (size_t)chain * 128 * 64;
  const bf16* TM = (const bf16*)(ws + WS_TM) + (size_t)chain * 128 * 4096;
  bf16* OD = (bf16*)P.out + (size_t)dir * M * DM + (size_t)b * SEQ * DM + h * 128;
  __syncthreads();
  if (wave >= 4) {
    const int lt = tid - 256;
    u32x4 rq[4], rk[4], rv[4], rt[2]; float rg = 0.f, rb = 0.f;
#define L_LOAD(n) do { _Pragma("unroll") for (int i = 0; i < 4; ++i) { const int id = lt + 256 * i, row = id >> 4, ck = id & 15; \
        const int pos = (n) * 64 + row, t = dir ? (SEQ - 1 - pos) : pos; const bf16* src = RAW + (size_t)t * 3072 + ck * 8; \
        rq[i] = __builtin_nontemporal_load((const u32x4*)src); rk[i] = __builtin_nontemporal_load((const u32x4*)(src + 1024)); rv[i] = __builtin_nontemporal_load((const u32x4*)(src + 2048)); } \
      _Pragma("unroll") for (int i = 0; i < 2; ++i) rt[i] = __builtin_nontemporal_load((const u32x4*)(TM + (size_t)(n) * 4096 + (lt + 256 * i) * 8)); \
      if (lt < 64) { const int pos = (n) * 64 + lt, t = dir ? (SEQ - 1 - pos) : pos; rg = GC[(n) * 64 + lt]; rb = GB[(size_t)t * 32 + dir * 8 + h]; } } while (0)
#define L_STORE(bf) do { char* bb = lds + (bf) * SB_SIZE; _Pragma("unroll") for (int i = 0; i < 4; ++i) { const int id = lt + 256 * i, row = id >> 4, ck = id & 15; \
        *(u32x2*)(bb + SB_QH + row * 264 + ck * 16) = u32x2{rq[i][0], rq[i][1]}; *(u32x2*)(bb + SB_QH + row * 264 + ck * 16 + 8) = u32x2{rq[i][2], rq[i][3]}; \
        *(u32x2*)(bb + SB_KH + row * 264 + ck * 16) = u32x2{rk[i][0], rk[i][1]}; *(u32x2*)(bb + SB_KH + row * 264 + ck * 16 + 8) = u32x2{rk[i][2], rk[i][3]}; \
        *(u32x4*)(bb + SB_VV + row * 256 + ck * 16) = rv[i]; } \
      _Pragma("unroll") for (int i = 0; i < 2; ++i) { const int id = lt + 256 * i, row = id >> 3, ck = id & 7; \
        *(u32x2*)(bb + SB_TT + row * 136 + ck * 16) = u32x2{rt[i][0], rt[i][1]}; *(u32x2*)(bb + SB_TT + row * 136 + ck * 16 + 8) = u32x2{rt[i][2], rt[i][3]}; } \
      if (lt < 64) { ((float*)(bb + SB_G))[lt] = rg; ((float*)(bb + SB_B))[lt] = rb; ((float*)(bb + SB_E1))[lt] = __expf(rg); ((float*)(bb + SB_E2))[lt] = __expf(__shfl(rg, 63) - rg); } } while (0)
    L_LOAD(0); L_STORE(0); L_LOAD(1);
    const int bi = (wave == 4 || wave == 7) ? 0 : 1, bj = (wave == 6 || wave == 7) ? 1 : 0;
    for (int n = 0; n < 128; ++n) {
      const int cur = n & 1;
      __syncthreads();
      { const char* bb = lds + cur * SB_SIZE; const float* sG = (const float*)(bb + SB_G);
        f32x16 a = {};
        if (wave != 7) {
#pragma unroll
          for (int s = 0; s < 8; ++s) a = MFMA(ldfragP(bb + SB_QH, 264, 32 * bi + r32, s * 16, hi), ldfragP(bb + SB_KH, 264, 32 * bj + r32, s * 16, hi), a);
        }
        const int j = 32 * bj + r32; const float Gj = sG[j];
        const int ib = 32 * bi + 4 * hi;
        const float* sGi = sG + ib; char* aqb = lds + SC_AQ + ib * 136 + j * 2;
#pragma unroll
        for (int r = 0; r < 16; ++r) {
          const float v = (wave != 7 && j <= ib + CRC(r)) ? a[r] * __expf(sGi[CRC(r)] - Gj) : 0.f;
          *(bf16*)(aqb + CRC(r) * 136) = f2bf(v);
        } }
      __syncthreads();
      if (n + 1 < 128) L_STORE(cur ^ 1);
      if (n + 2 < 128) L_LOAD(n + 2);
    }
#undef L_LOAD
#undef L_STORE
  } else {
    f32x16 S0 = {}, S1 = {}, S2 = {}, S3 = {};
    const int g16 = (lane >> 4) & 1, i16 = lane & 15;
    for (int n = 0; n < 128; ++n) {
      const int cur = n & 1;
      const char* bb = lds + cur * SB_SIZE;
      const float* sB4 = (const float*)(bb + SB_B) + 4 * hi; const float* sE14 = (const float*)(bb + SB_E1) + 4 * hi; const float* sE24 = (const float*)(bb + SB_E2) + 4 * hi;
      __syncthreads();
      f32x16 o0 = {}, o1 = {};
      bf16x8 vp00, vp01, vp10, vp11, vd00, vd01, vd10, vd11;
      {
        const bf16x8 sp00 = packacc<0>(S0), sp01 = packacc<1>(S0), sp10 = packacc<0>(S1), sp11 = packacc<1>(S1);
        const bf16x8 sp20 = packacc<0>(S2), sp21 = packacc<1>(S2), sp30 = packacc<0>(S3), sp31 = packacc<1>(S3);
        f32x16 k0 = {}, k1 = {};
#define KQ_STEP(TILE, A0, A1, DB, SS, SP) do { A0 = MFMA(ldfragP(bb + TILE, 264, r32, 32 * DB + 16 * SS, hi), SP, A0); \
                                              A1 = MFMA(ldfragP(bb + TILE, 264, 32 + r32, 32 * DB + 16 * SS, hi), SP, A1); } while (0)
        KQ_STEP(SB_KH, k0, k1, 0, 0, sp00); KQ_STEP(SB_KH, k0, k1, 0, 1, sp01); KQ_STEP(SB_KH, k0, k1, 1, 0, sp10); KQ_STEP(SB_KH, k0, k1, 1, 1, sp11);
        KQ_STEP(SB_KH, k0, k1, 2, 0, sp20); KQ_STEP(SB_KH, k0, k1, 2, 1, sp21); KQ_STEP(SB_KH, k0, k1, 3, 0, sp30); KQ_STEP(SB_KH, k0, k1, 3, 1, sp31);
        { const char* vvb = bb + SB_VV + (4 * hi) * 256 + (32 * wave + r32) * 2;
#pragma unroll
          for (int r = 0; r < 16; ++r) {
            k0[r] = sB4[CRC(r)] * (bf2f(*(const bf16*)(vvb + CRC(r) * 256)) - sE14[CRC(r)] * k0[r]);
            k1[r] = sB4[32 + CRC(r)] * (bf2f(*(const bf16*)(vvb + (32 + CRC(r)) * 256)) - sE14[32 + CRC(r)] * k1[r]);
          } }
        const bf16x8 rp00 = packacc<0>(k0), rp01 = packacc<1>(k0), rp10 = packacc<0>(k1), rp11 = packacc<1>(k1);
        f32x16 v0 = {}, v1 = {};
#define T_STEP(MB, SS, RP) do { v0 = MFMA(ldfragP(bb + SB_TT, 136, r32, 32 * MB + 16 * SS, hi), RP, v0); \
                                v1 = MFMA(ldfragP(bb + SB_TT, 136, 32 + r32, 32 * MB + 16 * SS, hi), RP, v1); } while (0)
        T_STEP(0, 0, rp00); T_STEP(0, 1, rp01); T_STEP(1, 0, rp10); T_STEP(1, 1, rp11);
        vp00 = packacc<0>(v0); vp01 = packacc<1>(v0); vp10 = packacc<0>(v1); vp11 = packacc<1>(v1);
#pragma unroll
        for (int r = 0; r < 16; ++r) { v0[r] *= sE24[CRC(r)]; v1[r] *= sE24[32 + CRC(r)]; }
        vd00 = packacc<0>(v0); vd01 = packacc<1>(v0); vd10 = packacc<0>(v1); vd11 = packacc<1>(v1);
        __builtin_amdgcn_sched_barrier(0);
        KQ_STEP(SB_QH, o0, o1, 0, 0, sp00); KQ_STEP(SB_QH, o0, o1, 0, 1, sp01); KQ_STEP(SB_QH, o0, o1, 1, 0, sp10); KQ_STEP(SB_QH, o0, o1, 1, 1, sp11);
        KQ_STEP(SB_QH, o0, o1, 2, 0, sp20); KQ_STEP(SB_QH, o0, o1, 2, 1, sp21); KQ_STEP(SB_QH, o0, o1, 3, 0, sp30); KQ_STEP(SB_QH, o0, o1, 3, 1, sp31);
#pragma unroll
        for (int r = 0; r < 16; ++r) { o0[r] *= sE14[CRC(r)]; o1[r] *= sE14[32 + CRC(r)]; }
      }
      __syncthreads();
#define A_STEP(MB, SS, VP) do { o0 = MFMA(ldfragP(lds + SC_AQ, 136, r32, 32 * MB + 16 * SS, hi), VP, o0); \
                                o1 = MFMA(ldfragP(lds + SC_AQ, 136, 32 + r32, 32 * MB + 16 * SS, hi), VP, o1); } while (0)
      A_STEP(0, 0, vp00); A_STEP(0, 1, vp01); A_STEP(1, 0, vp10); A_STEP(1, 1, vp11);
      { const int pb = n * 64 + 4 * hi, tb = dir ? (SEQ - 1 - pb) : pb;
        bf16* odb = OD + (size_t)tb * DM + 32 * wave + r32;
        const long sgn = dir ? -(long)DM : (long)DM;
#pragma unroll
        for (int r = 0; r < 16; ++r) { odb[sgn * CRC(r)] = (bf16)pk2(o0[r], 0.f); odb[sgn * (32 + CRC(r))] = (bf16)pk2(o1[r], 0.f); } }
      const float eg = ((const float*)(bb + SB_E1))[63];
#pragma unroll
      for (int r = 0; r < 16; ++r) { S0[r] *= eg; S1[r] *= eg; S2[r] *= eg; S3[r] *= eg; }
      { const lds_cptr kt = (lds_cptr)(bb + SB_KH) + (4 * hi + (i16 >> 2)) * 264 + (16 * g16 + 4 * (i16 & 3)) * 2;
#define S_STEP(SX, DB) do { SX = MFMA(ldfragT(kt + (DB) * 64), vd00, SX); SX = MFMA(ldfragT(kt + (DB) * 64 + 16 * 264), vd01, SX); \
                            SX = MFMA(ldfragT(kt + (DB) * 64 + 32 * 264), vd10, SX); SX = MFMA(ldfragT(kt + (DB) * 64 + 48 * 264), vd11, SX); } while (0)
        S_STEP(S0, 0); S_STEP(S1, 1); S_STEP(S2, 2); S_STEP(S3, 3); }
    }
#undef KQ_STEP
#undef T_STEP
#undef A_STEP
#undef S_STEP
  }
  __syncthreads();
}

namespace att {
constexpr int D = 128, NW = 8, QBLK = 32, KVBLK = 64;
constexpr float SCALE = 0.088388347648318440f;
constexpr float THR = 8.f;
constexpr int LDQ = 1024, LDK = 256, LDO = 1024;
constexpr size_t SHM_V = KVBLK * D * 2, SHM_K = KVBLK * D * 2, SHM_ATTN = 2 * SHM_V + 2 * SHM_K + NW * 64 * 4;
using f32x8 = __attribute__((ext_vector_type(8))) float;
#define KSWZ(row, colB) ((row) * 256 + ((colB) ^ (((row) & 7) << 4)))
#define SBAR() __builtin_amdgcn_sched_barrier(0)
DI unsigned cvtpk(float lo, float hi) { unsigned r; asm volatile("v_cvt_pk_bf16_f32 %0, %1, %2" : "=v"(r) : "v"(lo), "v"(hi)); return r; }
DI bf16x8 ld8(const bf16* p) { return *reinterpret_cast<const bf16x8*>(p); }

DI void partialSM(f32x16& p0, f32x16& p1, float mnC) {
  constexpr float C = SCALE * 1.4426950408889634f;
  asm volatile("" : "+v"(p0), "+v"(p1));
  for (int r = 0; r < 16; ++r) p0[r] = fmaf(p0[r], C, mnC); for (int r = 0; r < 16; ++r) p1[r] = fmaf(p1[r], C, mnC);
  for (int r = 0; r < 16; ++r) p0[r] = __builtin_amdgcn_exp2f(p0[r]);
}
DI void finishSM(f32x16& p0, f32x16& p1, float& l_reg, bf16x8& pa0, bf16x8& pa1, bf16x8& pa2, bf16x8& pa3) {
  for (int r = 0; r < 16; ++r) p1[r] = __builtin_amdgcn_exp2f(p1[r]);
  float ps = 0; for (int r = 0; r < 16; ++r) ps += p0[r]; for (int r = 0; r < 16; ++r) ps += p1[r];
  l_reg += ps;
#define PK4(P, BASE, OUT) do { unsigned a0 = cvtpk(P[BASE + 0], P[BASE + 1]), a1 = cvtpk(P[BASE + 2], P[BASE + 3]);   \
    unsigned b0 = cvtpk(P[BASE + 4], P[BASE + 5]), b1 = cvtpk(P[BASE + 6], P[BASE + 7]);                              \
    auto r0 = __builtin_amdgcn_permlane32_swap(a0, b0, false, false); auto r1 = __builtin_amdgcn_permlane32_swap(a1, b1, false, false); \
    u32x4 w = {r0[0], r1[0], r0[1], r1[1]}; OUT = *reinterpret_cast<bf16x8*>(&w); } while (0)
  PK4(p0, 0, pa0); PK4(p0, 8, pa1); PK4(p1, 0, pa2); PK4(p1, 8, pa3);
#undef PK4
}
DI void qkt(f32x16& p0, f32x16& p1, const bf16* Ks, const bf16x8* qr, int r32, int hi) {
  p0 = f32x16{}; p1 = f32x16{};
  for (int d0 = 0; d0 < 8; ++d0) { int cb = (d0 * 16 + hi * 8) * 2;
    bf16x8 b0 = *reinterpret_cast<const bf16x8*>((const char*)Ks + KSWZ(r32, cb));
    bf16x8 b1 = *reinterpret_cast<const bf16x8*>((const char*)Ks + KSWZ(32 + r32, cb));
    p0 = __builtin_amdgcn_mfma_f32_32x32x16_bf16(b0, qr[d0], p0, 0, 0, 0);
    p1 = __builtin_amdgcn_mfma_f32_32x32x16_bf16(b1, qr[d0], p1, 0, 0, 0); }
}
DI int v_st(int k, int c) { const int kk = (k & ~0xC) | ((k & 4) << 1) | ((k & 8) >> 1); return ((kk >> 3) * 4 + (c >> 5)) * 512 + ((kk & 7) * 32 + (c & 31)) * 2; }
DI int v_rd_base(int lane) { return ((lane & 3) << 3) | (((lane >> 2) & 3) << 6) | (((lane >> 4) & 1) << 5) | (((lane >> 5) & 1) << 8); }
constexpr int v_rd_off(int d0, int ks, int half) { return d0 * 512 + ks * 4096 + half * 2048; }
template <int OFF> DI s16x4 tr_read(int vb) {
  s16x4 r; asm volatile("ds_read_b64_tr_b16 %0, %1 offset:%2" : "=&v"(r) : "v"(vb), "i"(OFF) : "memory"); return r;
}
template <int D0> DI void pv_one(f32x16& od, int vb, bf16x8 pa0, bf16x8 pa1, bf16x8 pa2, bf16x8 pa3) {
  const s16x4 l0 = tr_read<v_rd_off(D0, 0, 0)>(vb), h0 = tr_read<v_rd_off(D0, 0, 1)>(vb), l1 = tr_read<v_rd_off(D0, 1, 0)>(vb), h1 = tr_read<v_rd_off(D0, 1, 1)>(vb);
  const s16x4 l2 = tr_read<v_rd_off(D0, 2, 0)>(vb), h2 = tr_read<v_rd_off(D0, 2, 1)>(vb), l3 = tr_read<v_rd_off(D0, 3, 0)>(vb), h3 = tr_read<v_rd_off(D0, 3, 1)>(vb);
  asm volatile("s_waitcnt lgkmcnt(0)" ::: "memory"); SBAR();
#define PK(L, H) (bf16x8){L[0], L[1], L[2], L[3], H[0], H[1], H[2], H[3]}
  od = __builtin_amdgcn_mfma_f32_32x32x16_bf16(pa0, PK(l0, h0), od, 0, 0, 0);
  od = __builtin_amdgcn_mfma_f32_32x32x16_bf16(pa1, PK(l1, h1), od, 0, 0, 0);
  od = __builtin_amdgcn_mfma_f32_32x32x16_bf16(pa2, PK(l2, h2), od, 0, 0, 0);
  od = __builtin_amdgcn_mfma_f32_32x32x16_bf16(pa3, PK(l3, h3), od, 0, 0, 0);
#undef PK
}
DI void pv_d0(f32x16* o, int vb, bf16x8 pa0, bf16x8 pa1, bf16x8 pa2, bf16x8 pa3) {
  pv_one<0>(o[0], vb, pa0, pa1, pa2, pa3); pv_one<1>(o[1], vb, pa0, pa1, pa2, pa3); pv_one<2>(o[2], vb, pa0, pa1, pa2, pa3); pv_one<3>(o[3], vb, pa0, pa1, pa2, pa3);
}

DI void attn_dense_body(const bf16* Qb, const bf16* __restrict__ Kh, const bf16* __restrict__ Vh, bf16* Ob, int ldo, float* ml, int seq, char* lds, float mnC) {
  constexpr int SDEPTH = 1;
  const int tid = threadIdx.x, wid = tid >> 6, lane = tid & 63, r32 = lane & 31, hi = lane >> 5;
  bf16* V_lds = (bf16*)lds; bf16* K_lds = (bf16*)(lds + 2 * SHM_V);
  float* ws = (float*)(lds + 2 * SHM_V + 2 * SHM_K) + wid * 64; float* li_l = ws; float* al_l = ws + 32;
  float l_reg = 0; f32x16 o[4] = {}; bf16x8 qr[8];
  const bf16* Qw = Qb + (long)(wid * QBLK + r32) * LDQ + hi * 8;
#pragma unroll
  for (int d0 = 0; d0 < 8; ++d0) qr[d0] = ld8(Qw + d0 * 16);
  const int sr = tid >> 4, sc = (tid & 15) * 8, vst0 = v_st(sr, sc), vst1 = v_st(32 + sr, sc);
  const int vb0 = (int)(uintptr_t)V_lds + v_rd_base(lane);
  struct { bf16x8 ks0, ks1; } sr_[SDEPTH];
#define SLOAD(i, k0) do { sr_[i].vs0 = ld8(&Vh[(long)((k0) + sr) * LDK + sc]); sr_[i].vs1 = ld8(&Vh[(long)((k0) + 32 + sr) * LDK + sc]); \
    sr_[i].ks0 = ld8(&Kh[(long)((k0) + sr) * LDK + sc]); sr_[i].ks1 = ld8(&Kh[(long)((k0) + 32 + sr) * LDK + sc]); } while (0)
#define SWRITE(b, i) do { *(bf16x8*)((char*)V_lds + (b) * SHM_V + vst0) = sr_[i].vs0;          \
    *(bf16x8*)((char*)V_lds + (b) * SHM_V + vst1) = sr_[i].vs1; int kc = sc * 2;               \
    *(bf16x8*)((char*)K_lds + (b) * SHM_K + KSWZ(sr, kc)) = sr_[i].ks0;                       \
    *(bf16x8*)((char*)K_lds + (b) * SHM_K + KSWZ(32 + sr, kc)) = sr_[i].ks1; } while (0)
#define SWAIT() do { asm volatile("s_waitcnt vmcnt(0)" ::: "memory"); } while (0)
  f32x16 pA0, pA1, pB0, pB1; bf16x8 pa0, pa1, pa2, pa3; const int NT = seq / KVBLK;
#define LOADK(k0) do { sr_[0].ks0 = ld8(&Kh[(long)((k0) + sr) * LDK + sc]); sr_[0].ks1 = ld8(&Kh[(long)((k0) + 32 + sr) * LDK + sc]); } while (0)
#define LOADV(k0) do { sr_[0].ks0 = ld8(&Vh[(long)((k0) + sr) * LDK + sc]); sr_[0].ks1 = ld8(&Vh[(long)((k0) + 32 + sr) * LDK + sc]); } while (0)
#define WRITEK(b) do { const int kc = sc * 2; *(bf16x8*)((char*)K_lds + (b) * SHM_K + KSWZ(sr, kc)) = sr_[0].ks0; *(bf16x8*)((char*)K_lds + (b) * SHM_K + KSWZ(32 + sr, kc)) = sr_[0].ks1; } while (0)
#define WRITEV(b) do { *(bf16x8*)((char*)V_lds + (b) * SHM_V + vst0) = sr_[0].ks0; *(bf16x8*)((char*)V_lds + (b) * SHM_V + vst1) = sr_[0].ks1; } while (0)
  {
    const bf16x8 a0 = ld8(&Kh[(long)sr * LDK + sc]), a1 = ld8(&Kh[(long)(32 + sr) * LDK + sc]);
    const bf16x8 b0 = ld8(&Vh[(long)sr * LDK + sc]), b1 = ld8(&Vh[(long)(32 + sr) * LDK + sc]);
    const bf16x8 c0 = ld8(&Kh[(long)(KVBLK + sr) * LDK + sc]), c1 = ld8(&Kh[(long)(KVBLK + 32 + sr) * LDK + sc]);
    LOADV(KVBLK);
    const int kc = sc * 2;
    *(bf16x8*)((char*)K_lds + KSWZ(sr, kc)) = a0; *(bf16x8*)((char*)K_lds + KSWZ(32 + sr, kc)) = a1;
    *(bf16x8*)((char*)V_lds + vst0) = b0; *(bf16x8*)((char*)V_lds + vst1) = b1;
    *(bf16x8*)((char*)K_lds + SHM_K + KSWZ(sr, kc)) = c0; *(bf16x8*)((char*)K_lds + SHM_K + KSWZ(32 + sr, kc)) = c1;
    __syncthreads(); }
  qkt(pA0, pA1, K_lds, qr, r32, hi); partialSM(pA0, pA1, mnC);
  for (int j = 1; j + 1 < NT; j += 2) {
    SBAR(); qkt(pB0, pB1, (bf16*)((char*)K_lds + SHM_K), qr, r32, hi);
    SWAIT(); WRITEV(1); LOADK((j + 1) * KVBLK);
    finishSM(pA0, pA1, l_reg, pa0, pa1, pa2, pa3); SBAR();
    pv_d0(o, vb0, pa0, pa1, pa2, pa3); partialSM(pB0, pB1, mnC);
    SWAIT(); WRITEK(0); LOADV((j + 1) * KVBLK); __syncthreads();
    SBAR(); qkt(pA0, pA1, K_lds, qr, r32, hi);
    SWAIT(); WRITEV(0); LOADK((j + 2) * KVBLK);
    finishSM(pB0, pB1, l_reg, pa0, pa1, pa2, pa3); SBAR();
    pv_d0(o, vb0 + (int)SHM_V, pa0, pa1, pa2, pa3); partialSM(pA0, pA1, mnC);
    SWAIT(); WRITEK(1); LOADV((j + 2) * KVBLK); __syncthreads();
  }
  SBAR(); qkt(pB0, pB1, (bf16*)((char*)K_lds + SHM_K), qr, r32, hi);
  finishSM(pA0, pA1, l_reg, pa0, pa1, pa2, pa3); SBAR();
  pv_d0(o, vb0, pa0, pa1, pa2, pa3); partialSM(pB0, pB1, mnC);
  SWAIT(); WRITEV(1); __syncthreads();
  finishSM(pB0, pB1, l_reg, pa0, pa1, pa2, pa3); SBAR();
  pv_d0(o, vb0 + (int)SHM_V, pa0, pa1, pa2, pa3);
#undef LOADK
#undef LOADV
#undef WRITEK
#undef WRITEV
  { auto rr = __builtin_amdgcn_permlane32_swap(__float_as_uint(l_reg), __float_as_uint(l_reg), false, false); l_reg = __uint_as_float(rr[0]) + __uint_as_float(rr[1]); }
  if (hi == 0) { li_l[r32] = l_reg; if (ml) { ml[(wid * QBLK + r32) * 2] = 0.f; ml[(wid * QBLK + r32) * 2 + 1] = l_reg; } }
  asm volatile("s_waitcnt lgkmcnt(0)" ::: "memory");
  float rli[16];
#pragma unroll
  for (int r = 0; r < 16; ++r) rli[r] = __builtin_amdgcn_rcpf(li_l[crow(r, hi)]);
  bf16* Ow = Ob + (long)(wid * QBLK) * ldo;
#pragma unroll
  for (int r = 0; r < 16; ++r) { int orow = crow(r, hi);
    for (int d0 = 0; d0 < 4; ++d0) Ow[(long)orow * ldo + d0 * 32 + r32] = f2bf(o[d0][r] * rli[r]); }
#undef SLOAD
#undef SWRITE
#undef SWAIT
#undef RESC
}
}

DI void phase_mix(const Params& P, char* lds) {
  char* ws = P.ws;
#ifndef NO_DELTA
  for (int chain = blockIdx.x; chain < 32; chain += gridDim.x) delta_chain(P, lds, chain);
#endif
  unsigned* counter = (unsigned*)(ws + WS_MISC + 65536);
  volatile int* su = (volatile int*)(lds + LDS_BYTES - 16);
  bf16* QA = (bf16*)(ws + WS_QA); const bf16* KA = (const bf16*)(ws + WS_KA); const bf16* VA = (const bf16*)(ws + WS_VA);
  float gq, gk;
  { const int ln = threadIdx.x & 63;
    gq = fmaxf(fabsf(P.q_norm[ln]), fabsf(P.q_norm[ln + 64])); gk = fmaxf(fabsf(P.k_norm[ln]), fabsf(P.k_norm[ln + 64]));
    for (int o = 32; o > 0; o >>= 1) { gq = fmaxf(gq, __shfl_xor(gq, o)); gk = fmaxf(gk, __shfl_xor(gk, o)); } }
  const float mnC = -(gq * gk * 11.313708499f * 1.02f + 0.1f) * 1.4426950408889634f;
  if (threadIdx.x == 0) *su = (int)atomicAdd(counter, 1u);
  __syncthreads();
  for (;;) {
    const int it = *su;
    if (it >= 704) break;
    int nxt = -1;
    if (threadIdx.x == 0 && it < 448) nxt = (int)atomicAdd(counter, 1u);
    const int u = it < 448 ? it : 448 + ((it - 448) >> 2), qtr = (it - 448) & 3;
    const int qb = u & 31, hq = (u >> 5) & 7, b = u >> 8, kvh = hq >> 2;
    bf16* q0 = QA + ((size_t)b * SEQ + qb * 256) * 1024 + hq * 128;
    const bf16* k0 = KA + (size_t)b * SEQ * 256 + kvh * 128;
    const bf16* v0 = VA + (size_t)b * SEQ * 256 + kvh * 128;
    if (it < 448) att::attn_dense_body(q0, k0, v0, q0, 1024, nullptr, SEQ, lds, mnC);
    else {
      const int pc = it - 448;
      att::attn_dense_body(q0, k0 + (size_t)qtr * 2048 * 256, v0 + (size_t)qtr * 2048 * 256, (bf16*)(ws + WS_PB) + (size_t)pc * 256 * 128, 128, (float*)(ws + WS_ML) + (size_t)pc * 512, 2048, lds, mnC);
    }
    __syncthreads();
    if (threadIdx.x == 0) *su = nxt >= 0 ? nxt : (int)atomicAdd(counter, 1u);
    __syncthreads();
  }
}

DI void phase_rownorm(const float* __restrict__ base, const bf16* __restrict__ src, const float* __restrict__ w, float* dst, bf16* dstb) {
  const int tid = threadIdx.x, wave = tid >> 6, lane = tid & 63;
  for (int row = blockIdx.x * 8 + wave; row < M; row += gridDim.x * 8) {
    const size_t ro = (size_t)row * DM;
    f32x4 v[4]; float ss = 0.f;
#pragma unroll
    for (int i = 0; i < 4; ++i) { const u32x2 sv = *(const u32x2*)(src + ro + i * 256 + lane * 4);
      v[i] = f32x4{__uint_as_float(sv[0] << 16), __uint_as_float(sv[0] & 0xffff0000u), __uint_as_float(sv[1] << 16), __uint_as_float(sv[1] & 0xffff0000u)};
      ss += v[i][0] * v[i][0] + v[i][1] * v[i][1] + v[i][2] * v[i][2] + v[i][3] * v[i][3]; }
    ss = wave_sum(ss);
    const float rstd = rsqrtf(ss * (1.f / DM) + EPS);
#pragma unroll
    for (int i = 0; i < 4; ++i) {
      const f32x4 ww = *(const f32x4*)(w + i * 256 + lane * 4);
      const f32x4 bb = *(const f32x4*)(base + ro + i * 256 + lane * 4);
      f32x4 o;
#pragma unroll
      for (int e = 0; e < 4; ++e) o[e] = bb[e] + v[i][e] * rstd * ww[e];
      *(f32x4*)(dst + ro + i * 256 + lane * 4) = o;
      if (dstb) { u32x2 ob = {pk2(o[0], o[1]), pk2(o[2], o[3])}; *(u32x2*)(dstb + ro + i * 256 + lane * 4) = ob; }
    }
  }
}

#define LAS __attribute__((address_space(3)))
#define XB_TMO      128
#define XB_XCNT(j)  (256  + 64 * (j))
#define XB_XSUB(j)  (1280 + 64 * (j))
#define XB_XGEN(j)  (2304 + 64 * (j))
#define XB_TOP      3328
#define XB_TOPGEN   3392
#define XCD_BAR_WORDS 3456
#define XB_SPIN_CAP (1u << 18)

__device__ __forceinline__ unsigned xb_ld(unsigned* p)              { return __hip_atomic_load(p, __ATOMIC_RELAXED, __HIP_MEMORY_SCOPE_AGENT); }
__device__ __forceinline__ unsigned xb_add(unsigned* p, unsigned v) { return __hip_atomic_fetch_add(p, v, __ATOMIC_RELAXED, __HIP_MEMORY_SCOPE_AGENT); }
__device__ __forceinline__ unsigned xb_xcc_id() { return (unsigned)__builtin_amdgcn_s_getreg((3 << 11) | 20) & 0xFu; }
#define XB_SPIN(cond, bar) do { unsigned _sp = 0; while (cond) { __builtin_amdgcn_s_sleep(1); \
    if ((++_sp & 255u) == 0u) { if (xb_ld(&(bar)[XB_TMO])) break; if (_sp > XB_SPIN_CAP) { atomicAdd(&(bar)[XB_TMO], 1u); break; } } } } while (0)

struct XcdBarrier {
    unsigned* bar; unsigned x;
    volatile LAS unsigned* st;
};

__device__ __forceinline__ XcdBarrier xcd_barrier_post(unsigned* bar, volatile LAS unsigned* st) {
    XcdBarrier b; b.bar = bar; b.x = xb_xcc_id(); b.st = st;
    if (threadIdx.x == 0) (void)xb_add(&bar[XB_XCNT(b.x)], 1u);
    return b;
}
__device__ __forceinline__ void xcd_barrier_complete(unsigned* bar, unsigned x, unsigned& nloc, unsigned& nx) {
    const unsigned G = gridDim.x * gridDim.y * gridDim.z;
    unsigned sum, cnt, mine, sp = 0u;
    for (;;) {
        sum = 0u; cnt = 0u; mine = 0u;
#pragma unroll
        for (unsigned j = 0; j < 16; ++j) { const unsigned c = xb_ld(&bar[XB_XCNT(j)]); sum += c; cnt += (c > 0u) ? 1u : 0u; mine = (j == x) ? c : mine; }
        if (sum == G) break;
        __builtin_amdgcn_s_sleep(1);
        if ((++sp & 255u) == 0u) { if (xb_ld(&bar[XB_TMO])) break; if (sp > XB_SPIN_CAP) { atomicAdd(&bar[XB_TMO], 1u); break; } }
    }
    nloc = mine > 0u ? mine : 1u; nx = cnt > 0u ? cnt : 1u;
}

__device__ __forceinline__ void xcd_barrier(const XcdBarrier& b) {
    asm volatile("s_waitcnt vmcnt(0)" ::: "memory");
    __syncthreads();
    if (threadIdx.x == 0) {
        unsigned* bar = b.bar;
        __builtin_amdgcn_s_waitcnt(0);
        unsigned nloc = b.st[0], nx = b.st[1];
        if (nloc == 0u) { xcd_barrier_complete(bar, b.x, nloc, nx); b.st[0] = nloc; b.st[1] = nx; }
        const unsigned old = xb_add(&bar[XB_XSUB(b.x)], 1u);
        const unsigned gen = old / nloc;
        if (old + 1u == (gen + 1u) * nloc) {
            __builtin_amdgcn_fence(__ATOMIC_RELEASE, "agent");
            asm volatile("s_waitcnt vmcnt(0)" ::: "memory");
            const unsigned og = xb_add(&bar[XB_TOP], 1u);
            const unsigned tg = og / nx;
            if (og + 1u == (tg + 1u) * nx) xb_add(&bar[XB_TOPGEN], 1u);
            else XB_SPIN(xb_ld(&bar[XB_TOPGEN]) == tg, bar);
            __builtin_amdgcn_fence(__ATOMIC_ACQUIRE, "agent");
            xb_add(&bar[XB_XGEN(b.x)], 1u);
            asm volatile("s_waitcnt vmcnt(0)" ::: "memory");
        } else {
            XB_SPIN(xb_ld(&bar[XB_XGEN(b.x)]) == gen, bar);
            __builtin_amdgcn_fence(__ATOMIC_ACQUIRE, "agent");
            asm volatile("s_waitcnt vmcnt(0)" ::: "memory");
        }
    }
    __syncthreads();
}

__global__ void __launch_bounds__(512) mega(Params P) {
  extern __shared__ __attribute__((aligned(16))) char lds[];
  cg::grid_group grid = cg::this_grid();
#ifndef PHMASK
#define PHMASK 0x7ff
#endif
#define PH(k) ((((PHMASK) >> (k)) & 1) && P.ph_lo <= (k) && (k) < P.ph_hi)
  volatile LAS unsigned* bst = (volatile LAS unsigned*)(lds + LDS_BYTES - 32);
  if (threadIdx.x == 0) { bst[0] = 0u; bst[1] = 0u; }
  __syncthreads();
  const XcdBarrier bar = xcd_barrier_post((unsigned*)(P.ws + WS_BAR), bst);
#define SYNC(k) do { if (PH(k) && PH((k) + 1)) xcd_barrier(bar); } while (0)
  if (P.ph_hi > 1000) grid.sync();
  char* ws = P.ws;
  if (PH(0)) phase0(P, lds);
  SYNC(0);
  if (PH(1)) phase_g1(P, lds);
  SYNC(1);
  if (PH(2)) phase_conv(P, lds);
  SYNC(2);
  if (PH(3)) phase_d1(P, lds);
  SYNC(3);
  if (PH(4)) phase_mix(P, lds);
  SYNC(4);
  if (PH(5)) phase_g3(P, lds);
  SYNC(5);
  if (PH(6)) phase_g4(P, lds);
  SYNC(6);
  if (PH(7)) phase_g5(P, lds);
  SYNC(7);
  if (PH(8)) { phase_rownorm(P.x, (const bf16*)(ws + WS_MIXO), P.norm_post, P.out, (bf16*)(ws + WS_X1B)); phase_pconv(P); }
  SYNC(8);
  if (PH(9)) phase_g6(P, lds);
  SYNC(9);
  if (PH(10)) phase_rownorm(P.out, (const bf16*)(ws + WS_MIXO), P.ple_norm, P.out, nullptr);
}

extern "C" void kernel_launch(void* const* d_in, const int* in_sizes, int n_in, void* d_out, int out_size, void* d_ws, size_t ws_size, hipStream_t stream) {
  static int grid_blocks = 0;
  if (grid_blocks == 0) {
    if (n_in != 17 || out_size != M * DM || ws_size < WS_END) { fprintf(stderr, "kernel_launch: unexpected shapes (n_in %d out %d ws %zu)\n", n_in, out_size, ws_size); grid_blocks = -1; return; }
    int dev = 0, cus = 0, per_cu = 0;
    hipGetDevice(&dev);
    hipDeviceGetAttribute(&cus, hipDeviceAttributeMultiprocessorCount, dev);
    if (hipFuncSetAttribute((const void*)mega, hipFuncAttributeMaxDynamicSharedMemorySize, LDS_BYTES) != hipSuccess) { fprintf(stderr, "kernel_launch: hipFuncSetAttribute failed\n"); grid_blocks = -1; return; }
    if (hipOccupancyMaxActiveBlocksPerMultiprocessor(&per_cu, (const void*)mega, 512, LDS_BYTES) != hipSuccess || per_cu < 1) { fprintf(stderr, "kernel_launch: occupancy query gave %d\n", per_cu); per_cu = 1; }
    (void)hipGetLastError();
    grid_blocks = cus * per_cu;
  }
  if (grid_blocks < 0) return;
  Params p{};
  p.x = (const float*)d_in[0]; p.p = (const float*)d_in[1]; p.norm_pre = (const float*)d_in[2]; p.w_in = (const float*)d_in[3];
  p.q_norm = (const float*)d_in[4]; p.k_norm = (const float*)d_in[5]; p.conv_w = (const float*)d_in[6]; p.a_log = (const float*)d_in[7];
  p.dt_bias = (const float*)d_in[8]; p.dn_norm = (const float*)d_in[9]; p.w_br_att = (const float*)d_in[10]; p.w_br_dn = (const float*)d_in[11];
  p.w_out = (const float*)d_in[12]; p.norm_post = (const float*)d_in[13]; p.w_ple_proj = (const float*)d_in[14]; p.w_ple_gate = (const float*)d_in[15];
  p.ple_norm = (const float*)d_in[16];
  p.out = (float*)d_out; p.ws = (char*)d_ws; p.ph_lo = 0; p.ph_hi = 11;
  if (hipMemsetAsync((char*)d_ws + WS_MISC + 65536, 0, 65536 + 16384, stream) != hipSuccess) { fprintf(stderr, "kernel_launch: memset failed\n"); return; }
  void* args[] = {&p};
  hipError_t e = hipLaunchCooperativeKernel((const void*)mega, dim3(grid_blocks), dim3(512), args, LDS_BYTES, stream);
  if (e != hipSuccess) fprintf(stderr, "kernel_launch: cooperative launch failed: %s (grid %d)\n", hipGetErrorString(e), grid_blocks);
}
```
